# Optimizing an MI355X kernel written in HIP

```python
import jax, jax.numpy as jnp
from jax import lax
import numpy as np

D_MODEL = 1024
BATCH = 2
SEQ = 8192
DEPTH = 1
DEC_BATCH = 8
DEC_SEQ = 32
PAST_LEN = 4096

CHUNK = 64
D_MIX = D_MODEL
D_CONV = D_MIX // 2
CONV_W = 3
N_HEADS = 8
HEAD_DIM = (D_MIX - D_CONV) // N_HEADS
N_KV_HEADS = 2
GROUP = N_HEADS // N_KV_HEADS
IDX_HEADS = 8
IDX_DIM = 64
TOPK_MAX = 256
Q_BLOCK = 128
N_MEM = 256
MEM_HEADS = 4
MEM_HEAD_DIM = D_MODEL // MEM_HEADS
D_FF = 2816
ALPHA = (2.0 * DEPTH) ** 0.25
BETA = (8.0 * DEPTH) ** -0.25
LN_EPS = 1e-5
MIX_SPLITS = (D_CONV, D_CONV, D_CONV, N_HEADS * HEAD_DIM, N_KV_HEADS * HEAD_DIM,
              N_KV_HEADS * HEAD_DIM, IDX_HEADS * IDX_DIM, IDX_DIM, IDX_HEADS)
D_MIX_IN = sum(MIX_SPLITS)

kernel_name = "hybrid_conv_dsa_streaming_step"


def _layer_norm(x, g, b):
    xf = x.astype(jnp.float32)
    mu = xf.mean(-1, keepdims=True)
    var = jnp.square(xf - mu).mean(-1, keepdims=True)
    y = (xf - mu) * lax.rsqrt(var + LN_EPS) * g.astype(jnp.float32) + b.astype(jnp.float32)
    return y.astype(x.dtype)


def _swiglu(x, w_gate, w_up, w_down):
    return (jax.nn.silu(x @ w_gate) * (x @ w_up)) @ w_down


def _dsa_attention(q, k, v, qi, ki, wi, q_pos, k_pos, top_k):
    b, t = q.shape[:2]
    qb = min(Q_BLOCK, t)
    nb = t // qb
    k_chunk = k_pos // CHUNK
    gather = jax.vmap(lambda rows, ids: rows[ids])

    def blocks(a):
        return a.reshape((b, nb, qb) + a.shape[2:]).swapaxes(0, 1)

    def one_block(args):
        q_b, qi_b, wi_b, qpos_b = args
        q_chunk = qpos_b // CHUNK
        logits = jnp.einsum('bqhd,bsd->bqsh', qi_b, ki)
        score = jnp.einsum('bqsh,bqh->bqs', jax.nn.relu(logits), wi_b).astype(jnp.float32)
        admissible = k_chunk[None, :] <= q_chunk[:, None]
        score = jnp.where(admissible[None], score, -jnp.inf)
        _, idx = lax.top_k(score, top_k)
        k_sel = gather(k, idx)
        v_sel = gather(v, idx)
        valid = k_chunk[idx] <= q_chunk[None, :, None]
        s = jnp.einsum('bqhgd,bqkhd->bqhgk', q_b, k_sel).astype(jnp.float32) * (HEAD_DIM ** -0.5)
        s = jnp.where(valid[:, :, None, None, :], s, -jnp.inf)
        p = jax.nn.softmax(s, axis=-1).astype(v.dtype)
        return jnp.einsum('bqhgk,bqkhd->bqhgd', p, v_sel)

    out = lax.map(one_block, (blocks(q), blocks(qi), blocks(wi), q_pos.reshape(nb, qb)))
    return out.swapaxes(0, 1).reshape(q.shape)


def _mem_attention(x, mem_k, mem_v, w_q, w_o):
    b, t, _ = x.shape
    q = (x @ w_q).reshape(b, t, MEM_HEADS, MEM_HEAD_DIM)
    s = jnp.einsum('bthd,bmhd->bhtm', q, mem_k).astype(jnp.float32) * (MEM_HEAD_DIM ** -0.5)
    p = jax.nn.softmax(s, axis=-1).astype(mem_v.dtype)
    o = jnp.einsum('bhtm,bmhd->bthd', p, mem_v).reshape(b, t, MEM_HEADS * MEM_HEAD_DIM)
    return o @ w_o


def _layer(x, conv_prev, k_past, v_past, ik_past, mem_k, mem_v, pos0, top_k, p):
    b, t, _ = x.shape
    x = _layer_norm(ALPHA * x + 0.5 * _swiglu(x, p['ffn1_gate'], p['ffn1_up'], p['ffn1_down']),
                    p['ln1_g'], p['ln1_b'])
    proj = x @ p['w_mix_in']
    h, gate_b, gate_c, q, k, v, qi, ki, wi = jnp.split(
        proj, np.cumsum(MIX_SPLITS)[:-1].tolist(), axis=-1)
    u = gate_c * h
    u_pad = jnp.concatenate([conv_prev, u], axis=1)
    w = p['conv_w']
    conv = sum(w[j] * u_pad[:, j:j + t] for j in range(CONV_W))
    y_conv = gate_b * conv
    new_conv = u_pad[:, -(CONV_W - 1):]
    q = q.reshape(b, t, N_KV_HEADS, GROUP, HEAD_DIM)
    k = k.reshape(b, t, N_KV_HEADS, HEAD_DIM)
    v = v.reshape(b, t, N_KV_HEADS, HEAD_DIM)
    qi = qi.reshape(b, t, IDX_HEADS, IDX_DIM)
    wi = wi * ((IDX_HEADS * IDX_DIM) ** -0.5)
    k_all = jnp.concatenate([k_past, k], axis=1)
    v_all = jnp.concatenate([v_past, v], axis=1)
    ki_all = jnp.concatenate([ik_past, ki], axis=1)
    q_pos = pos0 + jnp.arange(t)
    k_pos = jnp.arange(k_all.shape[1])
    y_attn = _dsa_attention(q, k_all, v_all, qi, ki_all, wi, q_pos, k_pos, top_k)
    y_attn = y_attn.reshape(b, t, N_HEADS * HEAD_DIM)
    mix = jnp.concatenate([y_conv, y_attn], axis=-1) @ p['w_mix_out']
    x = _layer_norm(ALPHA * x + mix, p['ln2_g'], p['ln2_b'])
    x = _layer_norm(ALPHA * x + _mem_attention(x, mem_k, mem_v, p['w_mem_q'], p['w_mem_o']),
                    p['ln3_g'], p['ln3_b'])
    x = _layer_norm(ALPHA * x + 0.5 * _swiglu(x, p['ffn2_gate'], p['ffn2_up'], p['ffn2_down']),
                    p['ln4_g'], p['ln4_b'])
    return x, new_conv, k, v, ki


def setup_inputs(seed: int = 0) -> dict:
    key = jax.random.key(seed)
    ks = iter(jax.random.split(key, 40))
    f32 = jnp.float32

    def nrm(shape, scale=1.0):
        return jax.random.normal(next(ks), shape, f32) * scale

    def gain():
        return 1.0 + nrm((DEPTH, D_MODEL), 0.05)

    def bias():
        return nrm((DEPTH, D_MODEL), 0.02)

    return {
        "x_prompt": nrm((BATCH, SEQ, D_MODEL)),
        "x_sample": nrm((DEC_BATCH, DEC_SEQ, D_MODEL)),
        "cache_conv": nrm((DEPTH, DEC_BATCH, CONV_W - 1, D_CONV)),
        "cache_k": nrm((DEPTH, DEC_BATCH, PAST_LEN, N_KV_HEADS, HEAD_DIM)),
        "cache_v": nrm((DEPTH, DEC_BATCH, PAST_LEN, N_KV_HEADS, HEAD_DIM)),
        "cache_idx_k": nrm((DEPTH, DEC_BATCH, PAST_LEN, IDX_DIM)),
        "cache_mem_k": nrm((DEPTH, DEC_BATCH, N_MEM, MEM_HEADS, MEM_HEAD_DIM)),
        "cache_mem_v": nrm((DEPTH, DEC_BATCH, N_MEM, MEM_HEADS, MEM_HEAD_DIM)),
        "mem_prompt": nrm((BATCH, N_MEM, D_MODEL)),
        "ffn1_gate": nrm((DEPTH, D_MODEL, D_FF), D_MODEL ** -0.5),
        "ffn1_up": nrm((DEPTH, D_MODEL, D_FF), D_MODEL ** -0.5),
        "ffn1_down": nrm((DEPTH, D_FF, D_MODEL), BETA * D_FF ** -0.5),
        "ln1_g": gain(), "ln1_b": bias(),
        "w_mix_in": nrm((DEPTH, D_MODEL, D_MIX_IN), D_MODEL ** -0.5),
        "conv_w": nrm((DEPTH, CONV_W, D_CONV), CONV_W ** -0.5),
        "w_mix_out": nrm((DEPTH, D_MIX, D_MODEL), BETA * D_MIX ** -0.5),
        "ln2_g": gain(), "ln2_b": bias(),
        "w_mem_q": nrm((DEPTH, D_MODEL, MEM_HEADS * MEM_HEAD_DIM), D_MODEL ** -0.5),
        "w_mem_k": nrm((DEPTH, D_MODEL, MEM_HEADS * MEM_HEAD_DIM), D_MODEL ** -0.5),
        "w_mem_v": nrm((DEPTH, D_MODEL, MEM_HEADS * MEM_HEAD_DIM), D_MODEL ** -0.5),
        "w_mem_o": nrm((DEPTH, MEM_HEADS * MEM_HEAD_DIM, D_MODEL), BETA * D_MODEL ** -0.5),
        "ln3_g": gain(), "ln3_b": bias(),
        "ffn2_gate": nrm((DEPTH, D_MODEL, D_FF), D_MODEL ** -0.5),
        "ffn2_up": nrm((DEPTH, D_MODEL, D_FF), D_MODEL ** -0.5),
        "ffn2_down": nrm((DEPTH, D_FF, D_MODEL), BETA * D_FF ** -0.5),
        "ln4_g": gain(), "ln4_b": bias(),
    }


def reference(x_prompt, x_sample, cache_conv, cache_k, cache_v, cache_idx_k, cache_mem_k, cache_mem_v,
              mem_prompt, ffn1_gate, ffn1_up, ffn1_down, ln1_g, ln1_b, w_mix_in, conv_w, w_mix_out,
              ln2_g, ln2_b, w_mem_q, w_mem_k, w_mem_v, w_mem_o, ln3_g, ln3_b,
              ffn2_gate, ffn2_up, ffn2_down, ln4_g, ln4_b):
    b_p, t_p, _ = x_prompt.shape
    top_k_prompt = min(TOPK_MAX, t_p // 4)
    top_k_sample = min(TOPK_MAX, (cache_k.shape[2] + x_sample.shape[1]) // 4)
    past = cache_k.shape[2]
    y_p, y_s = x_prompt, x_sample
    conv_p, k_p, v_p, ik_p, mk_p, mv_p = [], [], [], [], [], []
    conv_s, k_s, v_s, ik_s = [], [], [], []
    for l in range(DEPTH):
        p = dict(ffn1_gate=ffn1_gate[l], ffn1_up=ffn1_up[l], ffn1_down=ffn1_down[l],
                 ln1_g=ln1_g[l], ln1_b=ln1_b[l], w_mix_in=w_mix_in[l], conv_w=conv_w[l],
                 w_mix_out=w_mix_out[l], ln2_g=ln2_g[l], ln2_b=ln2_b[l],
                 w_mem_q=w_mem_q[l], w_mem_o=w_mem_o[l], ln3_g=ln3_g[l], ln3_b=ln3_b[l],
                 ffn2_gate=ffn2_gate[l], ffn2_up=ffn2_up[l], ffn2_down=ffn2_down[l],
                 ln4_g=ln4_g[l], ln4_b=ln4_b[l])
        mem_k = (mem_prompt @ w_mem_k[l]).reshape(b_p, N_MEM, MEM_HEADS, MEM_HEAD_DIM)
        mem_v = (mem_prompt @ w_mem_v[l]).reshape(b_p, N_MEM, MEM_HEADS, MEM_HEAD_DIM)
        dt = x_prompt.dtype
        y_p, c_new, k_new, v_new, ik_new = _layer(
            y_p, jnp.zeros((b_p, CONV_W - 1, D_CONV), dt),
            jnp.zeros((b_p, 0, N_KV_HEADS, HEAD_DIM), dt), jnp.zeros((b_p, 0, N_KV_HEADS, HEAD_DIM), dt),
            jnp.zeros((b_p, 0, IDX_DIM), dt), mem_k, mem_v, 0, top_k_prompt, p)
        conv_p.append(c_new); k_p.append(k_new); v_p.append(v_new); ik_p.append(ik_new)
        mk_p.append(mem_k); mv_p.append(mem_v)
        y_s, c_new, k_new, v_new, ik_new = _layer(
            y_s, cache_conv[l], cache_k[l], cache_v[l], cache_idx_k[l],
            cache_mem_k[l], cache_mem_v[l], past, top_k_sample, p)
        conv_s.append(c_new); k_s.append(k_new); v_s.append(v_new); ik_s.append(ik_new)
    return (y_p, y_s,
            jnp.stack(conv_p), jnp.stack(k_p), jnp.stack(v_p), jnp.stack(ik_p),
            jnp.stack(mk_p), jnp.stack(mv_p),
            jnp.stack(conv_s), jnp.stack(k_s), jnp.stack(v_s), jnp.stack(ik_s))
```

```cpp
#include <hip/hip_runtime.h>
#include <cstdio>
#include <cstdint>

#ifndef MK_N_LAUNCHES
#define MK_N_LAUNCHES 1
#endif

#define LAS __attribute__((address_space(3)))
typedef unsigned short bf16_t;
typedef short bf16x8 __attribute__((ext_vector_type(8)));
typedef short s16x4 __attribute__((ext_vector_type(4)));
typedef float f32x4 __attribute__((ext_vector_type(4)));
typedef float f32x2 __attribute__((ext_vector_type(2)));
typedef float f32x16 __attribute__((ext_vector_type(16)));
typedef unsigned u32x4 __attribute__((ext_vector_type(4)));
typedef unsigned u32x2 __attribute__((ext_vector_type(2)));
typedef __bf16 bf16x2_t __attribute__((ext_vector_type(2)));

constexpr int D = 1024, SEQ = 8192, NBATCH = 2, MP = NBATCH * SEQ;
constexpr int DEC_B = 8, DEC_T = 32, MS = DEC_B * DEC_T, PAST = 4096;
constexpr int M = MP + MS;
constexpr int FF = 2816, NGU = 2 * FF;
constexpr int DCONV = 512, NMIX = 3072, NMIX_SRC = 2888;
constexpr int SKS = PAST + DEC_T;
constexpr int TOPK = 256;
constexpr float ALPHA = 1.189207115002721f;
constexpr float LN_EPS = 1e-5f;
constexpr float WI_SCALE = 0.04419417382415922f;

constexpr size_t O_Y = 0;
constexpr size_t O_CONVP = (size_t)M * D;
constexpr size_t O_KP = O_CONVP + 2 * 2 * DCONV;
constexpr size_t O_VP = O_KP + (size_t)MP * 128;
constexpr size_t O_IKP = O_VP + (size_t)MP * 128;
constexpr size_t O_MKP = O_IKP + (size_t)MP * 64;
constexpr size_t O_MVP = O_MKP + (size_t)2 * 256 * 1024;
constexpr size_t O_CONVS = O_MVP + (size_t)2 * 256 * 1024;
constexpr size_t O_KS = O_CONVS + 8 * 2 * DCONV;
constexpr size_t O_VS = O_KS + (size_t)MS * 128;
constexpr size_t O_IKS = O_VS + (size_t)MS * 128;
constexpr size_t O_END = O_IKS + (size_t)MS * 64;

constexpr size_t WS_CTL = 0, CTL_BYTES = 1u << 20;
constexpr size_t WS_WGU1 = WS_CTL + CTL_BYTES;
constexpr size_t WS_WD1 = WS_WGU1 + (size_t)NGU * D * 2;
constexpr size_t WS_WGU2 = WS_WD1 + (size_t)D * FF * 2;
constexpr size_t WS_WD2 = WS_WGU2 + (size_t)NGU * D * 2;
constexpr size_t WS_WMIX = WS_WD2 + (size_t)D * FF * 2;
constexpr size_t WS_WMO = WS_WMIX + (size_t)NMIX * D * 2;
constexpr size_t WS_WQ = WS_WMO + (size_t)D * D * 2;
constexpr size_t WS_WK = WS_WQ + (size_t)D * D * 2;
constexpr size_t WS_WV = WS_WK + (size_t)D * D * 2;
constexpr size_t WS_WO = WS_WV + (size_t)D * D * 2;
constexpr size_t WS_XB = WS_WO + (size_t)D * D * 2;
constexpr size_t WS_MEMPB = WS_XB + (size_t)M * D * 2;
constexpr size_t WS_KS = WS_MEMPB + (size_t)512 * D * 2;
constexpr size_t WS_VS = WS_KS + (size_t)DEC_B * SKS * 128 * 2;
constexpr size_t WS_KIS = WS_VS + (size_t)DEC_B * SKS * 128 * 2;
constexpr size_t WS_MK = WS_KIS + (size_t)DEC_B * SKS * 64 * 2;
constexpr size_t WS_MVT = WS_MK + (size_t)10 * 4 * 65536 * 2;
constexpr size_t WS_OV = WS_MVT + (size_t)10 * 4 * 65536 * 2;
constexpr size_t WS_HB = WS_OV;
constexpr size_t WS_U = WS_OV;
constexpr size_t WS_BG = WS_U + (size_t)M * 512 * 2;
constexpr size_t WS_QB = WS_BG + (size_t)M * 512 * 2;
constexpr size_t WS_QIB = WS_QB + (size_t)M * 512 * 2;
constexpr size_t WS_KP = WS_QIB + (size_t)M * 512 * 2;
constexpr size_t WS_VP = WS_KP + (size_t)MP * 128 * 2;
constexpr size_t WS_KIP = WS_VP + (size_t)MP * 128 * 2;
constexpr size_t WS_WIF = WS_KIP + (size_t)MP * 64 * 2;
constexpr size_t WS_SEL = WS_WIF + (size_t)M * 8 * 4;
constexpr size_t WS_YCAT = WS_SEL + (size_t)M * 256 * 2;
constexpr size_t WS_OVB_END = WS_YCAT + (size_t)M * D * 2;
constexpr size_t WS_QM = WS_OV;
constexpr size_t WS_PM = WS_QM + (size_t)M * D * 2;
constexpr size_t WS_OM = WS_PM + (size_t)M * D * 2;
constexpr size_t WS_OVC_END = WS_OM + (size_t)M * D * 2;
constexpr size_t WS_OVA_END = WS_HB + (size_t)M * FF * 2;
constexpr size_t cmax(size_t a, size_t b) { return a > b ? a : b; }
constexpr size_t WS_END = cmax(WS_OVA_END, cmax(WS_OVB_END, WS_OVC_END));
static_assert(WS_END <= 268435456ull, "d_ws map exceeds 256 MiB");
static_assert(WS_OV % 256 == 0 && WS_KP % 256 == 0 && WS_SEL % 256 == 0, "alignment");

constexpr int LDS_BYTES = 163840;
constexpr int NWAVES = 8;

__device__ __forceinline__ unsigned cvtpk(float lo, float hi) { f32x2 v = {lo, hi}; bf16x2_t b = __builtin_convertvector(v, bf16x2_t); return __builtin_bit_cast(unsigned, b); }
__device__ __forceinline__ int fresh_tid() { int t = threadIdx.x; asm volatile("" : "+v"(t)); return t; }
__device__ __forceinline__ float bf2f(unsigned short h) { return __uint_as_float((unsigned)h << 16); }

namespace pg8 {
constexpr int BM = 256, BK = 64, HALF = 128, HTB = HALF * BK * 2, STAGE_BYTES = 8 * HTB, NXCD = 8, WGM = 8;
__host__ __device__ __forceinline__ int lds_byte(int r, int c) { const int st = (r >> 4) * 2 + (c >> 5), rr = r & 15, cc = c & 31, ob = rr * 64 + cc * 2; return st * 1024 + (ob ^ (((ob >> 9) & 1) << 5)); }
__host__ __device__ __forceinline__ void stage_rc(int b, int& R, int& C) { const int st = b / 1024, sb = b % 1024, swz = sb ^ (((sb >> 9) & 1) << 5); R = (st >> 1) * 16 + swz / 64; C = (st & 1) * 32 + (swz % 64) / 2; }

struct Unit { int pm, pn, aux; const char* a; const char* b; };
struct Gemm { int lda, ldb, K; };

struct StaticOrder {
    int nM, nN, nwg, G, c; const char* A; const char* Bt; size_t sa, sb;
    __device__ __forceinline__ void init(const void* A_, const void* Bt_, int lda, int ldb, int M_, int N_, int G_, int c_) { nM = M_ / BM; nN = N_ / BM; nwg = nM * nN; G = G_; c = c_; A = (const char*)A_; Bt = (const char*)Bt_; sa = (size_t)BM * lda * 2; sb = (size_t)BM * ldb * 2; }
    __device__ __forceinline__ bool next(int i, Unit& u) const {
        const long L = (long)i * G + c; if (L >= nwg) return false;
        int wgid = (int)L; { const int q = nwg / NXCD, r = nwg % NXCD, xcd = wgid % NXCD, off = wgid / NXCD; wgid = (xcd < r ? xcd * (q + 1) : r * (q + 1) + (xcd - r) * q) + off; }
        const int nig = WGM * nN, gid = wgid / nig, fm = gid * WGM, gsz = (nM - fm) < WGM ? (nM - fm) : WGM;
        u.pm = fm + ((wgid % nig) % gsz); u.pn = (wgid % nig) / gsz; u.aux = 0; u.a = A + (size_t)u.pm * sa; u.b = Bt + (size_t)u.pn * sb; return true;
    }
};
struct OneUnit { Unit u0; __device__ __forceinline__ bool next(int i, Unit& u) const { if (i) return false; u = u0; return true; } };

template <class Epi, class Sched, bool ALIGN_EPI, bool SP2>
__device__ __forceinline__ void gemm_phase(LAS unsigned char* lds, const Gemm g, const Sched& S, const Epi& E) {
    const int tid = fresh_tid(), wid = __builtin_amdgcn_readfirstlane(tid >> 6), lane = tid & 63, wr = wid >> 2, wc = wid & 3, fr = lane & 15, fq = lane >> 4;
    const int K = g.K, nt = K / BK;
    unsigned voffA[2], voffB[2];
#pragma unroll
    for (int i = 0; i < 2; ++i) { int R, C; stage_rc(tid * 16 + i * 8192, R, C); voffA[i] = (unsigned)(R * g.lda + C) * 2u; voffB[i] = (unsigned)(R * g.ldb + C) * 2u; }
    const size_t kstep = (size_t)(BK * 2);
    const size_t hstepA = (size_t)HALF * g.lda * 2, hstepB = (size_t)HALF * g.ldb * 2;
    const unsigned ldsw = (unsigned)wid * 1024u;
    const int aoff = lds_byte(wr * 64 + fr, fq * 8), boff = lds_byte(wc * 32 + fr, fq * 8);
#define PG8_SA(b, h) (((b) * 2 + (h)) * HTB)
#define PG8_SB(b, h) ((4 + (b) * 2 + (h)) * HTB)
#define PG8_STAGE(bufoff, gbase, voff) do { _Pragma("unroll") for (int _i = 0; _i < 2; ++_i) \
        __builtin_amdgcn_global_load_lds((const unsigned*)((const char*)(gbase) + (voff)[_i]), (LAS unsigned*)(lds + (bufoff) + ldsw + _i * 8192), 16, 0, 0); } while (0)
#define PG8_LDA(dst, b, h) do { _Pragma("unroll") for (int m = 0; m < 4; ++m) _Pragma("unroll") for (int k = 0; k < 2; ++k) dst[m][k] = *(const LAS bf16x8*)(lds + PG8_SA(b, h) + aoff + m * 2048 + k * 1024); } while (0)
#define PG8_LDB(dst, b, h) do { _Pragma("unroll") for (int n = 0; n < 2; ++n) _Pragma("unroll") for (int k = 0; k < 2; ++k) dst[n][k] = *(const LAS bf16x8*)(lds + PG8_SB(b, h) + boff + n * 2048 + k * 1024); } while (0)
#define PG8_MMA(ai, bj, At, Bt) do { __builtin_amdgcn_s_setprio(1); _Pragma("unroll") for (int m = 0; m < 4; ++m) _Pragma("unroll") for (int n = 0; n < 2; ++n) _Pragma("unroll") for (int k = 0; k < 2; ++k) \
        acc[ai][bj][m][n] = __builtin_amdgcn_mfma_f32_16x16x32_bf16(Bt[n][k], At[m][k], acc[ai][bj][m][n], 0, 0, 0); __builtin_amdgcn_s_setprio(0); } while (0)
#define PG8_WAIT_V(n) asm volatile("s_waitcnt vmcnt(" #n ")" ::: "memory")
#define PG8_WAIT_L(n) asm volatile("s_waitcnt lgkmcnt(" #n ")" ::: "memory")
#define PG8_BAR __builtin_amdgcn_s_barrier()
#define PG8_SCHED __builtin_amdgcn_sched_barrier(0)
    Unit cur, nxt; int ui = 0;
    if (!S.next(0, cur)) return;
    f32x4 acc[2][2][4][2];
#pragma unroll
    for (int a = 0; a < 2; ++a)
#pragma unroll
        for (int b = 0; b < 2; ++b)
#pragma unroll
            for (int m = 0; m < 4; ++m)
#pragma unroll
                for (int n = 0; n < 2; ++n) acc[a][b][m][n] = (f32x4){0.f, 0.f, 0.f, 0.f};
    bf16x8 At[4][2], B0[2][2], B1[2][2];
    const char* cA = cur.a; const char* cB = cur.b;
    if constexpr (SP2) {
        PG8_STAGE(PG8_SB(0, 0), cB, voffB); PG8_STAGE(PG8_SB(0, 1), cB + hstepB, voffB); PG8_STAGE(PG8_SA(0, 0), cA, voffA); PG8_STAGE(PG8_SA(0, 1), cA + hstepA, voffA);
        if (wr == 1) PG8_BAR;
        PG8_WAIT_V(2); PG8_BAR;
        PG8_STAGE(PG8_SB(1, 0), cB + kstep, voffB); PG8_STAGE(PG8_SA(1, 0), cA + kstep, voffA); PG8_STAGE(PG8_SB(1, 1), cB + hstepB + kstep, voffB);
        PG8_WAIT_V(6); PG8_BAR;
    } else {
        PG8_STAGE(PG8_SB(0, 0), cB, voffB); PG8_STAGE(PG8_SA(0, 0), cA, voffA); PG8_STAGE(PG8_SB(0, 1), cB + hstepB, voffB); PG8_STAGE(PG8_SA(0, 1), cA + hstepA, voffA);
        if (wr == 1) PG8_BAR;
        PG8_WAIT_V(4); PG8_BAR;
        PG8_STAGE(PG8_SB(1, 0), cB + kstep, voffB); PG8_STAGE(PG8_SA(1, 0), cA + kstep, voffA); PG8_STAGE(PG8_SB(1, 1), cB + hstepB + kstep, voffB);
        PG8_WAIT_V(6); PG8_BAR;
    }
    for (;;) {
        const bool has_next = S.next(ui + 1, nxt);
        const char* nA = has_next ? nxt.a : cA; const char* nB = has_next ? nxt.b : cB;
        for (int t = 0; t < nt; t += 2) {
            const bool last = (t == nt - 2);
            const char* a1 = cA + (size_t)(t + 1) * kstep;
            const char* a2 = last ? nA : cA + (size_t)(t + 2) * kstep; const char* b2 = last ? nB : cB + (size_t)(t + 2) * kstep;
            const char* a3 = a2 + kstep; const char* b3 = b2 + kstep;
            if constexpr (SP2) {
            PG8_LDB(B0, 0, 0); PG8_LDB(B1, 0, 1); PG8_SCHED; PG8_LDA(At, 0, 0); PG8_STAGE(PG8_SA(1, 1), a1 + hstepA, voffA);
            PG8_WAIT_V(8); PG8_WAIT_L(0); PG8_BAR; PG8_MMA(0, 0, At, B0); PG8_MMA(0, 1, At, B1); PG8_BAR; PG8_SCHED;
            PG8_LDA(At, 0, 1); PG8_STAGE(PG8_SB(0, 0), b2, voffB); PG8_STAGE(PG8_SB(0, 1), b2 + hstepB, voffB); PG8_STAGE(PG8_SA(0, 0), a2, voffA);
            PG8_WAIT_V(8); PG8_WAIT_L(0); PG8_BAR; PG8_MMA(1, 0, At, B0); PG8_MMA(1, 1, At, B1); PG8_BAR; PG8_SCHED;
            PG8_LDB(B0, 1, 0); PG8_LDB(B1, 1, 1); PG8_SCHED; PG8_LDA(At, 1, 0); PG8_STAGE(PG8_SA(0, 1), a2 + hstepA, voffA);
            PG8_WAIT_V(8); PG8_WAIT_L(0); PG8_BAR; PG8_MMA(0, 0, At, B0); PG8_MMA(0, 1, At, B1); PG8_BAR; PG8_SCHED;
            PG8_LDA(At, 1, 1); PG8_STAGE(PG8_SB(1, 0), b3, voffB); PG8_STAGE(PG8_SB(1, 1), b3 + hstepB, voffB); PG8_STAGE(PG8_SA(1, 0), a3, voffA);
            PG8_WAIT_V(8); PG8_WAIT_L(0); PG8_BAR; PG8_MMA(1, 0, At, B0); PG8_MMA(1, 1, At, B1); PG8_BAR; PG8_SCHED;
            } else {
            PG8_LDB(B0, 0, 0); PG8_SCHED; PG8_LDA(At, 0, 0); PG8_STAGE(PG8_SA(1, 1), a1 + hstepA, voffA);
            PG8_WAIT_L(8); PG8_BAR; PG8_WAIT_L(0); PG8_MMA(0, 0, At, B0); PG8_BAR; PG8_SCHED;
            PG8_LDB(B1, 0, 1); PG8_STAGE(PG8_SB(0, 0), b2, voffB);
            PG8_BAR; PG8_WAIT_L(0); PG8_MMA(0, 1, At, B1); PG8_BAR;
            PG8_LDA(At, 0, 1); PG8_STAGE(PG8_SA(0, 0), a2, voffA);
            PG8_BAR; PG8_WAIT_L(0); PG8_MMA(1, 0, At, B0); PG8_BAR; PG8_SCHED;
            PG8_STAGE(PG8_SB(0, 1), b2 + hstepB, voffB);
            PG8_WAIT_V(6); PG8_BAR; PG8_MMA(1, 1, At, B1); PG8_BAR;
            PG8_LDB(B0, 1, 0); PG8_SCHED; PG8_LDA(At, 1, 0); PG8_STAGE(PG8_SA(0, 1), a2 + hstepA, voffA);
            PG8_WAIT_L(8); PG8_BAR; PG8_WAIT_L(0); PG8_MMA(0, 0, At, B0); PG8_BAR; PG8_SCHED;
            PG8_LDB(B1, 1, 1); PG8_STAGE(PG8_SB(1, 0), b3, voffB);
            PG8_BAR; PG8_WAIT_L(0); PG8_MMA(0, 1, At, B1); PG8_BAR;
            PG8_LDA(At, 1, 1); PG8_STAGE(PG8_SA(1, 0), a3, voffA);
            PG8_BAR; PG8_WAIT_L(0); PG8_MMA(1, 0, At, B0); PG8_BAR; PG8_SCHED;
            PG8_STAGE(PG8_SB(1, 1), b3 + hstepB, voffB);
            PG8_WAIT_V(6); PG8_BAR; PG8_MMA(1, 1, At, B1); PG8_BAR;
            }
        }
        if constexpr (ALIGN_EPI) { if (wr == 0) PG8_BAR; }
        if constexpr (!Epi::AFTER_DRAIN) { E(acc, cur, wr, wc, fr, fq); }
        if (!has_next) break;
#pragma unroll
        for (int a = 0; a < 2; ++a)
#pragma unroll
            for (int b = 0; b < 2; ++b)
#pragma unroll
                for (int m = 0; m < 4; ++m)
#pragma unroll
                    for (int n = 0; n < 2; ++n) acc[a][b][m][n] = (f32x4){0.f, 0.f, 0.f, 0.f};
        cur = nxt; cA = nA; cB = nB; ++ui;
        if constexpr (ALIGN_EPI) { if (wr == 1) PG8_BAR; }
    }
    PG8_WAIT_V(0);
    if constexpr (!ALIGN_EPI) { if (wr == 0) PG8_BAR; }
    PG8_BAR;
    if constexpr (Epi::AFTER_DRAIN) { E.fused(acc, cur, wr, wc, fr, fq, lds, wid, lane); }
#undef PG8_SA
#undef PG8_SB
#undef PG8_STAGE
#undef PG8_LDA
#undef PG8_LDB
#undef PG8_MMA
#undef PG8_WAIT_V
#undef PG8_WAIT_L
#undef PG8_BAR
#undef PG8_SCHED
}
}

typedef f32x4 Acc[2][2][4][2];
#define EPI_FOR(...) _Pragma("unroll") for (int ai = 0; ai < 2; ++ai) _Pragma("unroll") for (int m = 0; m < 4; ++m) { const int ROW = u.pm * 256 + ai * 128 + wr * 64 + m * 16 + fr; \
    _Pragma("unroll") for (int bj = 0; bj < 2; ++bj) _Pragma("unroll") for (int n = 0; n < 2; ++n) { const int LC = bj * 128 + wc * 32 + n * 16 + fq * 4; const f32x4 V = acc[ai][bj][m][n]; __VA_ARGS__ } }

__device__ __forceinline__ void st_bf16x4(bf16_t* p, f32x4 v) { u32x2 w; w.x = cvtpk(v[0], v[1]); w.y = cvtpk(v[2], v[3]); *(u32x2*)p = w; }

struct EpiGateUp {
    static constexpr bool AFTER_DRAIN = false;
    bf16_t* H;
    __device__ __forceinline__ void operator()(const Acc& acc, const pg8::Unit& u, int wr, int wc, int fr, int fq) const {
#pragma unroll
        for (int ai = 0; ai < 2; ++ai)
#pragma unroll
            for (int m = 0; m < 4; ++m) { const int row = u.pm * 256 + ai * 128 + wr * 64 + m * 16 + fr;
#pragma unroll
                for (int n = 0; n < 2; ++n) { const f32x4 g = acc[ai][0][m][n], up = acc[ai][1][m][n]; f32x4 h;
#pragma unroll
                    for (int e = 0; e < 4; ++e) { const float s = g[e] / (1.f + __expf(-g[e])); h[e] = s * up[e]; }
                    st_bf16x4(H + (size_t)row * FF + u.pn * 128 + wc * 32 + n * 16 + fq * 4, h); } }
    }
};
struct EpiResid {
    static constexpr bool AFTER_DRAIN = false;
    const float* resP; const float* resS; float* X; float scale;
    __device__ __forceinline__ void operator()(const Acc& acc, const pg8::Unit& u, int wr, int wc, int fr, int fq) const {
        EPI_FOR({ const int col = u.pn * 256 + LC; const float* rp = (ROW < MP) ? resP + (size_t)ROW * D + col : resS + (size_t)(ROW - MP) * D + col;
                  const f32x4 r = *(const f32x4*)rp; *(f32x4*)(X + (size_t)ROW * D + col) = r * ALPHA + V * scale; })
    }
};
struct EpiBf16 {
    static constexpr bool AFTER_DRAIN = false;
    bf16_t* O; int ldc;
    __device__ __forceinline__ void operator()(const Acc& acc, const pg8::Unit& u, int wr, int wc, int fr, int fq) const {
        EPI_FOR({ st_bf16x4(O + (size_t)ROW * ldc + u.pn * 256 + LC, V); })
    }
};
struct EpiMemKV {
    static constexpr bool AFTER_DRAIN = false;
    float* outK; float* outV;
    __device__ __forceinline__ void operator()(const Acc& acc, const pg8::Unit& u, int wr, int wc, int fr, int fq) const {
        float* o = u.aux ? outV : outK;
        EPI_FOR({ *(f32x4*)(o + (size_t)ROW * D + u.pn * 256 + LC) = V; })
    }
};
struct EpiMixIn {
    static constexpr bool AFTER_DRAIN = false;
    float* out; unsigned char* ws;
    __device__ __forceinline__ void operator()(const Acc& acc, const pg8::Unit& u, int wr, int wc, int fr, int fq) const {
        const int pn = u.pn; const bool samp = (u.pm == 64);
        if (pn < 4) {
            bf16_t* U = (bf16_t*)(ws + WS_U);
#pragma unroll
            for (int ai = 0; ai < 2; ++ai)
#pragma unroll
                for (int m = 0; m < 4; ++m) { const int row = u.pm * 256 + ai * 128 + wr * 64 + m * 16 + fr;
#pragma unroll
                    for (int n = 0; n < 2; ++n) { const f32x4 uu = acc[ai][0][m][n] * acc[ai][1][m][n]; const int ch = pn * 128 + wc * 32 + n * 16 + fq * 4;
                        st_bf16x4(U + (size_t)row * 512 + ch, uu);
                        if (ai == 1 && m == 3) {
                            if (!samp) { const int t = row & (SEQ - 1); if (t >= SEQ - 2) *(f32x4*)(out + O_CONVP + (size_t)((row >> 13) * 2 + (t - (SEQ - 2))) * DCONV + ch) = uu; } }
                        if (samp && (m & 1)) { const int rs = row - MP, t = rs & 31; if (t >= 30) *(f32x4*)(out + O_CONVS + (size_t)((rs >> 5) * 2 + (t - 30)) * DCONV + ch) = uu; } } }
        } else if (pn == 8) {
#pragma unroll
            for (int bj = 0; bj < 2; ++bj) {
                float* fo = out + (samp ? (bj ? O_VS : O_KS) : (bj ? O_VP : O_KP)) - (samp ? (size_t)MP * 128 : 0);
                bf16_t* bo = (bf16_t*)(ws + (samp ? (bj ? WS_VS : WS_KS) : (bj ? WS_VP : WS_KP)));
#pragma unroll
                for (int ai = 0; ai < 2; ++ai)
#pragma unroll
                    for (int m = 0; m < 4; ++m) { const int row = u.pm * 256 + ai * 128 + wr * 64 + m * 16 + fr; const int rs = row - MP;
                        const size_t brow = samp ? ((size_t)(rs >> 5) * SKS + PAST + (rs & 31)) : (size_t)row;
#pragma unroll
                        for (int n = 0; n < 2; ++n) { const int c = wc * 32 + n * 16 + fq * 4; const f32x4 V = acc[ai][bj][m][n];
                            *(f32x4*)(fo + (size_t)row * 128 + c) = V; st_bf16x4(bo + brow * 128 + c, V); } } }
        } else if (pn == 11) {
            if (wc < 2) {
                float* fo = out + (samp ? O_IKS : O_IKP) - (samp ? (size_t)MP * 64 : 0);
                bf16_t* bo = (bf16_t*)(ws + (samp ? WS_KIS : WS_KIP));
#pragma unroll
                for (int ai = 0; ai < 2; ++ai)
#pragma unroll
                    for (int m = 0; m < 4; ++m) { const int row = u.pm * 256 + ai * 128 + wr * 64 + m * 16 + fr; const int rs = row - MP;
                        const size_t brow = samp ? ((size_t)(rs >> 5) * SKS + PAST + (rs & 31)) : (size_t)row;
#pragma unroll
                        for (int n = 0; n < 2; ++n) { const int c = wc * 32 + n * 16 + fq * 4; const f32x4 V = acc[ai][0][m][n];
                            *(f32x4*)(fo + (size_t)row * 64 + c) = V; st_bf16x4(bo + brow * 64 + c, V); } }
            } else if (wc == 2) {
                float* wf = (float*)(ws + WS_WIF);
#pragma unroll
                for (int ai = 0; ai < 2; ++ai)
#pragma unroll
                    for (int m = 0; m < 4; ++m) { const int row = u.pm * 256 + ai * 128 + wr * 64 + m * 16 + fr;
                        if (fq < 2) *(f32x4*)(wf + (size_t)row * 8 + fq * 4) = acc[ai][0][m][0] * WI_SCALE; }
            }
        } else {
            bf16_t* O = (bf16_t*)(ws + (pn < 6 ? WS_BG : pn < 8 ? WS_QB : WS_QIB)) + ((pn == 5 || pn == 7 || pn == 10) ? 256 : 0);
            EPI_FOR({ st_bf16x4(O + (size_t)ROW * 512 + LC, V); })
        }
    }
};
struct EpiSoftmaxP {
    static constexpr bool AFTER_DRAIN = true;
    bf16_t* P;
    __device__ __forceinline__ void operator()(const Acc&, const pg8::Unit&, int, int, int, int) const {}
    __device__ __forceinline__ void fused(Acc& acc, const pg8::Unit& u, int wr, int wc, int fr, int fq, LAS unsigned char* lds, int wid, int lane) const {
        LAS f32x2* PT = (LAS f32x2*)lds;
        LAS f32x2* ST = (LAS f32x2*)(lds + 8192);
        const float c = 0.0625f * 1.4426950408889634f;
#pragma unroll
        for (int ai = 0; ai < 2; ++ai)
#pragma unroll
            for (int m = 0; m < 4; ++m) {
                float mx = -INFINITY;
#pragma unroll
                for (int bj = 0; bj < 2; ++bj)
#pragma unroll
                    for (int n = 0; n < 2; ++n) { const f32x4 x = acc[ai][bj][m][n]; mx = fmaxf(mx, fmaxf(fmaxf(x[0], x[1]), fmaxf(x[2], x[3]))); }
                mx = fmaxf(mx, __shfl_xor(mx, 16)); mx = fmaxf(mx, __shfl_xor(mx, 32));
                float s = 0.f;
#pragma unroll
                for (int bj = 0; bj < 2; ++bj)
#pragma unroll
                    for (int n = 0; n < 2; ++n) { const f32x4 x = acc[ai][bj][m][n];
#pragma unroll
                        for (int e = 0; e < 4; ++e) s += __builtin_amdgcn_exp2f((x[e] - mx) * c); }
                s += __shfl_xor(s, 16); s += __shfl_xor(s, 32);
                if (fq == 0) PT[(ai * 128 + wr * 64 + m * 16 + fr) * 4 + wc] = (f32x2){mx, s};
            }
        __syncthreads();
        if (threadIdx.x < 256) { const int row = threadIdx.x; const f32x2 a = PT[row * 4], b = PT[row * 4 + 1], cc = PT[row * 4 + 2], d = PT[row * 4 + 3];
            const float mt = fmaxf(fmaxf(a.x, b.x), fmaxf(cc.x, d.x));
            const float l = a.y * __builtin_amdgcn_exp2f((a.x - mt) * c) + b.y * __builtin_amdgcn_exp2f((b.x - mt) * c) + cc.y * __builtin_amdgcn_exp2f((cc.x - mt) * c) + d.y * __builtin_amdgcn_exp2f((d.x - mt) * c);
            ST[row] = (f32x2){mt, 1.f / l}; }
        __syncthreads();
#pragma unroll
        for (int ai = 0; ai < 2; ++ai)
#pragma unroll
            for (int m = 0; m < 4; ++m) { const int rl = ai * 128 + wr * 64 + m * 16 + fr; const f32x2 st = ST[rl]; const int row = u.pm * 256 + rl;
                if (u.aux < 0 || (ai * 4 + wr * 2 + (m >> 1)) == u.aux) {
#pragma unroll
                    for (int bj = 0; bj < 2; ++bj)
#pragma unroll
                        for (int n = 0; n < 2; ++n) { const f32x4 x = acc[ai][bj][m][n]; f32x4 p;
#pragma unroll
                            for (int e = 0; e < 4; ++e) p[e] = __builtin_amdgcn_exp2f((x[e] - st.x) * c) * st.y;
                            st_bf16x4(P + (size_t)row * D + u.pn * 256 + bj * 128 + wc * 32 + n * 16 + fq * 4, p); } } }
        __syncthreads();
    }
};
struct EpiBf16Filt {
    static constexpr bool AFTER_DRAIN = false;
    bf16_t* O;
    __device__ __forceinline__ void operator()(const Acc& acc, const pg8::Unit& u, int wr, int wc, int fr, int fq) const {
#pragma unroll
        for (int ai = 0; ai < 2; ++ai)
#pragma unroll
            for (int m = 0; m < 4; ++m) { if (u.aux >= 0 && (ai * 4 + wr * 2 + (m >> 1)) != u.aux) continue;
                const int row = u.pm * 256 + ai * 128 + wr * 64 + m * 16 + fr;
#pragma unroll
                for (int bj = 0; bj < 2; ++bj)
#pragma unroll
                    for (int n = 0; n < 2; ++n) st_bf16x4(O + (size_t)row * D + u.pn * 256 + bj * 128 + wc * 32 + n * 16 + fq * 4, acc[ai][bj][m][n]); }
    }
};
struct MemOrder {
    const char* A; const char* B; int G, c;
    __device__ __forceinline__ bool get(int L, pg8::Unit& u) const {
        if (L >= 288) return false;
        int pm, h, slot, aux;
        if (L < 256) { pm = L >> 2; h = L & 3; slot = pm >> 5; aux = -1; } else { const int j = L - 256; pm = 64; h = j & 3; aux = j >> 2; slot = 2 + aux; }
        u.pm = pm; u.pn = h; u.aux = aux; u.a = A + ((size_t)pm * 256 * D + h * 256) * 2; u.b = B + ((size_t)slot * 256 * D + h * 256) * 2; return true;
    }
    __device__ __forceinline__ bool next(int i, pg8::Unit& u) const { return get(i * G + c, u); }
};

#define XB_TMO      128
#define XB_XCNT(j)  (256  + 64 * (j))
#define XB_XSUB(j)  (1280 + 64 * (j))
#define XB_XGEN(j)  (2304 + 64 * (j))
#define XB_TOP      3328
#define XB_TOPGEN   3392
#define XCD_BAR_WORDS 3456
#define XB_SPIN_CAP (1u << 18)
__device__ __forceinline__ unsigned xb_ld(unsigned* p)              { return __hip_atomic_load(p, __ATOMIC_RELAXED, __HIP_MEMORY_SCOPE_AGENT); }
__device__ __forceinline__ unsigned xb_add(unsigned* p, unsigned v) { return __hip_atomic_fetch_add(p, v, __ATOMIC_RELAXED, __HIP_MEMORY_SCOPE_AGENT); }
__device__ __forceinline__ unsigned xb_xcc_id() { return (unsigned)__builtin_amdgcn_s_getreg((3 << 11) | 20) & 0xFu; }
#define XB_SPIN(cond, bar) do { unsigned _sp = 0; while (cond) { __builtin_amdgcn_s_sleep(1); \
    if ((++_sp & 255u) == 0u) { if (xb_ld(&(bar)[XB_TMO])) break; if (_sp > XB_SPIN_CAP) { atomicAdd(&(bar)[XB_TMO], 1u); break; } } } } while (0)
struct XcdBarrier { unsigned* bar; unsigned x; volatile LAS unsigned* st; };
__device__ __forceinline__ XcdBarrier xcd_barrier_post(unsigned* bar, volatile LAS unsigned* st) {
    XcdBarrier b; b.bar = bar; b.x = xb_xcc_id(); b.st = st;
    if (threadIdx.x == 0) (void)xb_add(&bar[XB_XCNT(b.x)], 1u);
    return b;
}
__device__ __forceinline__ void xcd_barrier_complete(unsigned* bar, unsigned x, unsigned& nloc, unsigned& nx) {
    const unsigned G = gridDim.x * gridDim.y * gridDim.z;
    unsigned sum, cnt, mine, sp = 0u;
    for (;;) {
        sum = 0u; cnt = 0u; mine = 0u;
#pragma unroll
        for (unsigned j = 0; j < 16; ++j) { const unsigned c = xb_ld(&bar[XB_XCNT(j)]); sum += c; cnt += (c > 0u) ? 1u : 0u; mine = (j == x) ? c : mine; }
        if (sum == G) break;
        __builtin_amdgcn_s_sleep(1);
        if ((++sp & 255u) == 0u) { if (xb_ld(&bar[XB_TMO])) break; if (sp > XB_SPIN_CAP) { atomicAdd(&bar[XB_TMO], 1u); break; } }
    }
    nloc = mine > 0u ? mine : 1u; nx = cnt > 0u ? cnt : 1u;
}
__device__ __forceinline__ void xcd_barrier(const XcdBarrier& b) {
    asm volatile("s_waitcnt vmcnt(0)" ::: "memory");
    __syncthreads();
    if (threadIdx.x == 0) {
        unsigned* bar = b.bar;
        __builtin_amdgcn_s_waitcnt(0);
        unsigned nloc = b.st[0], nx = b.st[1];
        if (nloc == 0u) { xcd_barrier_complete(bar, b.x, nloc, nx); b.st[0] = nloc; b.st[1] = nx; }
        const unsigned old = xb_add(&bar[XB_XSUB(b.x)], 1u);
        const unsigned gen = old / nloc;
        if (old + 1u == (gen + 1u) * nloc) {
            __builtin_amdgcn_fence(__ATOMIC_RELEASE, "agent");
            asm volatile("s_waitcnt vmcnt(0)" ::: "memory");
            const unsigned og = xb_add(&bar[XB_TOP], 1u);
            const unsigned tg = og / nx;
            if (og + 1u == (tg + 1u) * nx) xb_add(&bar[XB_TOPGEN], 1u);
            else XB_SPIN(xb_ld(&bar[XB_TOPGEN]) == tg, bar);
            __builtin_amdgcn_fence(__ATOMIC_ACQUIRE, "agent");
            xb_add(&bar[XB_XGEN(b.x)], 1u);
            asm volatile("s_waitcnt vmcnt(0)" ::: "memory");
        } else {
            XB_SPIN(xb_ld(&bar[XB_XGEN(b.x)]) == gen, bar);
            __builtin_amdgcn_fence(__ATOMIC_ACQUIRE, "agent");
            asm volatile("s_waitcnt vmcnt(0)" ::: "memory");
        }
    }
    __syncthreads();
}

struct Args { const float* in[30]; float* out; unsigned char* ws; int ph_lo, ph_hi; };

__device__ __forceinline__ float wave_sum(float v) {
#pragma unroll
    for (int o = 1; o < 64; o <<= 1) v += __shfl_xor(v, o);
    return v;
}
__device__ __forceinline__ void transpose_item(const float* colp, int ldw, int k0, bf16_t* WT, int K, int n0, LAS float* scr, int lane) {
#pragma unroll 8
    for (int i = 0; i < 32; ++i) { const int kk = 2 * i + (lane >> 5); scr[kk * 33 + (lane & 31)] = colp ? colp[(size_t)(k0 + kk) * ldw] : 0.f; }
    asm volatile("s_waitcnt lgkmcnt(0)" ::: "memory");
    const int c = lane & 7;
#pragma unroll
    for (int j = 0; j < 4; ++j) { const int n = (lane >> 3) + 8 * j; const LAS float* s = scr + (8 * c) * 33 + n;
        u32x4 o; o.x = cvtpk(s[0 * 33], s[1 * 33]); o.y = cvtpk(s[2 * 33], s[3 * 33]); o.z = cvtpk(s[4 * 33], s[5 * 33]); o.w = cvtpk(s[6 * 33], s[7 * 33]);
        *(u32x4*)(WT + (size_t)(n0 + n) * K + k0 + 8 * c) = o; }
    asm volatile("s_waitcnt lgkmcnt(0)" ::: "memory");
}
__device__ __forceinline__ int mix_src_col(int n) {
    const int pn = n >> 8, lc = n & 255;
    if (pn < 4) return (lc < 128) ? (pn * 128 + lc) : (1024 + pn * 128 + (lc - 128));
    if (pn < 6) return 512 + (pn - 4) * 256 + lc;
    if (pn < 8) return 1536 + (pn - 6) * 256 + lc;
    if (pn == 8) return (lc < 128) ? (2048 + lc) : (2176 + (lc - 128));
    if (pn < 11) return 2304 + (pn - 9) * 256 + lc;
    return (lc < 72) ? (2816 + lc) : -1;
}
__device__ __forceinline__ void cvt_copy(const float* src, bf16_t* dst, size_t n8, int gthread, int nthreads) {
    for (size_t i = gthread; i < n8; i += nthreads) { const f32x4 a = *(const f32x4*)(src + i * 8), b = *(const f32x4*)(src + i * 8 + 4);
        u32x4 o; o.x = cvtpk(a[0], a[1]); o.y = cvtpk(a[2], a[3]); o.z = cvtpk(b[0], b[1]); o.w = cvtpk(b[2], b[3]); *(u32x4*)(dst + i * 8) = o; }
}

__device__ __forceinline__ void phase_prologue(const Args& A, LAS unsigned char* lds, int vcu, int G) {
    const int tid = fresh_tid(), lane = tid & 63, wave = __builtin_amdgcn_readfirstlane(tid >> 6);
    LAS float* scr = (LAS float*)(lds + wave * 16384);
    const int gw = vcu * NWAVES + wave, NGW = G * NWAVES;
    unsigned char* ws = A.ws;
    constexpr int I_GU = (D / 64) * (NGU / 32), I_DN = (FF / 64) * (D / 32), I_MIX = (D / 64) * (NMIX / 32), I_SQ = (D / 64) * (D / 32), I_MV = (256 / 64) * (D / 32);
    constexpr int NITEMS = 2 * I_GU + 2 * I_DN + I_MIX + 5 * I_SQ + 8 * I_MV;
    for (int it = gw; it < NITEMS; it += NGW) {
        int r = it;
        if (r < 2 * I_GU) { const int l = r / I_GU; r -= l * I_GU; const int nblk = NGU / 32, kb = r / nblk, nb = r % nblk, n = nb * 32 + (lane & 31);
            const int j = n >> 8, lc = n & 255; const float* W = A.in[(l ? 25 : 9) + (lc >> 7)]; const int col = j * 128 + (lc & 127);
            transpose_item(W + col, FF, kb * 64, (bf16_t*)(ws + (l ? WS_WGU2 : WS_WGU1)), D, nb * 32, scr, lane); continue; } r -= 2 * I_GU;
        if (r < 2 * I_DN) { const int l = r / I_DN; r -= l * I_DN; const int nblk = D / 32, kb = r / nblk, nb = r % nblk;
            transpose_item(A.in[l ? 27 : 11] + nb * 32 + (lane & 31), D, kb * 64, (bf16_t*)(ws + (l ? WS_WD2 : WS_WD1)), FF, nb * 32, scr, lane); continue; } r -= 2 * I_DN;
        if (r < I_MIX) { const int nblk = NMIX / 32, kb = r / nblk, nb = r % nblk; const int sc = mix_src_col(nb * 32 + (lane & 31));
            transpose_item(sc >= 0 ? A.in[14] + sc : nullptr, NMIX_SRC, kb * 64, (bf16_t*)(ws + WS_WMIX), D, nb * 32, scr, lane); continue; } r -= I_MIX;
        if (r < 5 * I_SQ) { const int w = r / I_SQ; r -= w * I_SQ; const int nblk = D / 32, kb = r / nblk, nb = r % nblk;
            const int src = (w == 0) ? 16 : 18 + w;
            const size_t dst = (w == 0) ? WS_WMO : (w == 1) ? WS_WQ : (w == 2) ? WS_WK : (w == 3) ? WS_WV : WS_WO;
            transpose_item(A.in[src] + nb * 32 + (lane & 31), D, kb * 64, (bf16_t*)(ws + dst), D, nb * 32, scr, lane); continue; } r -= 5 * I_SQ;
        { const int b = r / I_MV; r -= b * I_MV; const int nblk = D / 32, kb = r / nblk, nb = r % nblk;
            transpose_item(A.in[7] + (size_t)b * 256 * D + nb * 32 + (lane & 31), D, kb * 64, (bf16_t*)(ws + WS_MVT) + (size_t)(2 + b) * 256 * D + (nb >> 3) * 256, D, (nb & 7) * 32, scr, lane); }
    }
    const int gt = gw * 64 + lane, NT = NGW * 64;
    cvt_copy(A.in[0], (bf16_t*)(ws + WS_XB), (size_t)MP * D / 8, gt, NT);
    cvt_copy(A.in[1], (bf16_t*)(ws + WS_XB) + (size_t)MP * D, (size_t)MS * D / 8, gt, NT);
    cvt_copy(A.in[8], (bf16_t*)(ws + WS_MEMPB), (size_t)512 * D / 8, gt, NT);
    for (int b = 0; b < DEC_B; ++b) {
        cvt_copy(A.in[3] + (size_t)b * PAST * 128, (bf16_t*)(ws + WS_KS) + (size_t)b * SKS * 128, (size_t)PAST * 128 / 8, gt, NT);
        cvt_copy(A.in[4] + (size_t)b * PAST * 128, (bf16_t*)(ws + WS_VS) + (size_t)b * SKS * 128, (size_t)PAST * 128 / 8, gt, NT);
        cvt_copy(A.in[5] + (size_t)b * PAST * 64, (bf16_t*)(ws + WS_KIS) + (size_t)b * SKS * 64, (size_t)PAST * 64 / 8, gt, NT);
    }
    cvt_copy(A.in[6], (bf16_t*)(ws + WS_MK) + (size_t)2 * 256 * D, (size_t)DEC_B * 256 * D / 8, gt, NT);
}
__device__ __forceinline__ void phase_memconv(const Args& A, LAS unsigned char* lds, int vcu, int G) {
    const int tid = fresh_tid(), lane = tid & 63, wave = __builtin_amdgcn_readfirstlane(tid >> 6);
    LAS float* scr = (LAS float*)(lds + wave * 16384);
    const int gw = vcu * NWAVES + wave, NGW = G * NWAVES;
    unsigned char* ws = A.ws;
    constexpr int I_MV = (256 / 64) * (D / 32);
    for (int it = gw; it < 2 * I_MV; it += NGW) { const int b = it / I_MV, r = it - b * I_MV; const int nblk = D / 32, kb = r / nblk, nb = r % nblk;
        transpose_item(A.out + O_MVP + (size_t)b * 256 * D + nb * 32 + (lane & 31), D, kb * 64, (bf16_t*)(ws + WS_MVT) + (size_t)b * 256 * D + (nb >> 3) * 256, D, (nb & 7) * 32, scr, lane); }
    const int gt = gw * 64 + lane, NT = NGW * 64;
    cvt_copy(A.out + O_MKP, (bf16_t*)(ws + WS_MK), (size_t)2 * 256 * D / 8, gt, NT);
}
__device__ __forceinline__ void phase_ln(float* X, bf16_t* XB, const float* g, const float* bta, int vcu, int G) {
    const int tid = fresh_tid(), lane = tid & 63, wave = __builtin_amdgcn_readfirstlane(tid >> 6);
    const int gw = vcu * NWAVES + wave, NGW = G * NWAVES;
    f32x4 gv[4], bv[4];
#pragma unroll
    for (int j = 0; j < 4; ++j) { gv[j] = *(const f32x4*)(g + 256 * j + 4 * lane); bv[j] = *(const f32x4*)(bta + 256 * j + 4 * lane); }
    for (int mrow = gw; mrow < M; mrow += NGW) {
        f32x4* xr = (f32x4*)(X + (size_t)mrow * D) + lane;
        f32x4 v[4]; float s = 0.f;
#pragma unroll
        for (int j = 0; j < 4; ++j) { v[j] = xr[64 * j]; s += (v[j][0] + v[j][1]) + (v[j][2] + v[j][3]); }
        const float mean = wave_sum(s) * (1.f / D); float s2 = 0.f;
#pragma unroll
        for (int j = 0; j < 4; ++j) { v[j] = v[j] - mean; s2 += (v[j][0] * v[j][0] + v[j][1] * v[j][1]) + (v[j][2] * v[j][2] + v[j][3] * v[j][3]); }
        const float rstd = 1.f / sqrtf(wave_sum(s2) * (1.f / D) + LN_EPS);
        u32x2* o8 = (u32x2*)(XB + (size_t)mrow * D) + lane;
#pragma unroll
        for (int j = 0; j < 4; ++j) { const f32x4 y = v[j] * rstd * gv[j] + bv[j]; xr[64 * j] = y; u32x2 w; w.x = cvtpk(y[0], y[1]); w.y = cvtpk(y[2], y[3]); o8[64 * j] = w; }
    }
}

constexpr int CAP = 1024;
constexpr int IDX_BUF = 0, IDX_STAGE = 32 * CAP * 4, IDX_HIST = IDX_STAGE + 2 * 8192, IDX_END = IDX_HIST + 8 * 1024;
static_assert(IDX_END <= LDS_BYTES, "indexer LDS");
__device__ __forceinline__ unsigned wave_maxu(unsigned v) {
#pragma unroll
    for (int o = 1; o < 64; o <<= 1) { const unsigned t = (unsigned)__shfl_xor((int)v, o); v = v > t ? v : t; }
    return v;
}
__device__ __forceinline__ unsigned wave_minu(unsigned v) {
#pragma unroll
    for (int o = 1; o < 64; o <<= 1) { const unsigned t = (unsigned)__shfl_xor((int)v, o); v = v < t ? v : t; }
    return v;
}
__device__ __forceinline__ unsigned wave_select256(LAS unsigned* buf, int n, LAS unsigned* hist, int lane) {
    unsigned e[16];
    unsigned lo = 0xFFFFFFFFu, hi = 0u;
#pragma unroll
    for (int i = 0; i < 16; ++i) { const int idx = i * 64 + lane; e[i] = (idx < n) ? buf[idx] : 0u; hi = e[i] > hi ? e[i] : hi; const unsigned x = (idx < n) ? e[i] : 0xFFFFFFFFu; lo = x < lo ? x : lo; }
    hi = wave_maxu(hi); lo = wave_minu(lo);
    int need = TOPK; unsigned T = lo;
    for (int pass = 0; pass < 5; ++pass) {
        const unsigned range = hi - lo;
        const int bits = range ? 32 - __builtin_clz(range) : 0;
        const int shift = bits > 8 ? bits - 8 : 0;
        *(LAS u32x4*)(hist + lane * 4) = (u32x4){0u, 0u, 0u, 0u};
#pragma unroll
        for (int i = 0; i < 16; ++i) if (e[i] >= lo && e[i] <= hi) __hip_atomic_fetch_add(hist + ((e[i] - lo) >> shift), 1u, __ATOMIC_RELAXED, __HIP_MEMORY_SCOPE_WORKGROUP);
        asm volatile("s_waitcnt lgkmcnt(0)" ::: "memory");
        const u32x4 hv = *(LAS u32x4*)(hist + lane * 4);
        const int s4 = (int)(hv.x + hv.y + hv.z + hv.w);
        int inc = s4;
#pragma unroll
        for (int d = 1; d < 64; d <<= 1) { const int t = __shfl_down(inc, d); if (lane + d < 64) inc += t; }
        const int exc = inc - s4;
        const unsigned long long mb = __builtin_amdgcn_ballot_w64(exc < need && inc >= need);
        const int L = mb ? __builtin_ctzll(mb) : 0;
        const int b3 = __builtin_amdgcn_readlane((int)hv.w, L), b2 = __builtin_amdgcn_readlane((int)hv.z, L), b1 = __builtin_amdgcn_readlane((int)hv.y, L), b0 = __builtin_amdgcn_readlane((int)hv.x, L);
        int above = __builtin_amdgcn_readlane(exc, L); int binT, cb;
        if (above + b3 >= need) { binT = 3; cb = b3; }
        else { above += b3; if (above + b2 >= need) { binT = 2; cb = b2; }
            else { above += b2; if (above + b1 >= need) { binT = 1; cb = b1; } else { above += b1; binT = 0; cb = b0; } } }
        binT += 4 * L;
        const unsigned lo2 = lo + ((unsigned)binT << shift);
        need -= above; T = lo2;
        if (shift == 0 || need == cb) break;
        unsigned hi2 = lo2 + ((1u << shift) - 1u); if (hi2 < lo2) hi2 = 0xFFFFFFFFu;
        hi = hi < hi2 ? hi : hi2; lo = lo2;
    }
    int pos = 0;
#pragma unroll
    for (int i = 0; i < 16; ++i) { const bool k = e[i] >= T && e[i] != 0u; const unsigned long long mk = __builtin_amdgcn_ballot_w64(k);
        const int pre = __builtin_amdgcn_mbcnt_hi((unsigned)(mk >> 32), __builtin_amdgcn_mbcnt_lo((unsigned)mk, 0u));
        if (k) buf[pos + pre] = e[i]; pos += __builtin_popcountll(mk); }
    asm volatile("s_waitcnt lgkmcnt(0)" ::: "memory");
    return T;
}
__device__ __forceinline__ void indexer_unit(LAS unsigned char* lds, const bf16_t* QI, const float* WI, int row0, const bf16_t* KI, int S, unsigned short* SEL) {
    const int tid = fresh_tid(), lane = tid & 63, wave = __builtin_amdgcn_readfirstlane(tid >> 6), h = lane >> 5, rho = lane & 31;
    LAS unsigned* bufw = (LAS unsigned*)(lds + IDX_BUF) + (size_t)(wave * 4) * CAP;
    LAS unsigned* hist = (LAS unsigned*)(lds + IDX_HIST) + wave * 256;
    const int ql = 2 * (rho >> 4) + ((rho >> 2) & 1), head = (rho & 3) + 4 * ((rho >> 3) & 1);
    bf16x8 a[4];
#pragma unroll
    for (int s = 0; s < 4; ++s) a[s] = *(const bf16x8*)(QI + (size_t)(row0 + wave * 4 + ql) * 512 + head * 64 + 16 * s + 8 * h);
    float wa[8], wb[8];
#pragma unroll
    for (int j = 0; j < 8; ++j) { wa[j] = WI[(size_t)(row0 + wave * 4 + h) * 8 + j]; wb[j] = WI[(size_t)(row0 + wave * 4 + 2 + h) * 8 + j]; }
    LAS unsigned* bufA = bufw + h * CAP; LAS unsigned* bufB = bufw + (2 + h) * CAP;
    unsigned tauA = 0u, tauB = 0u;
    int cnt0 = 0, cnt1 = 0, cnt2 = 0, cnt3 = 0;
    const int ntile = (S + 63) >> 6;
    const int skey = tid >> 3, schunk = tid & 7;
    const unsigned sdst = (unsigned)(skey * 128 + ((schunk ^ ((skey >> 1) & 7)) << 4));
    u32x4 pre = (skey < S) ? *(const u32x4*)(KI + (size_t)skey * 64 + schunk * 8) : (u32x4){0u, 0u, 0u, 0u};
    for (int t = 0; t < ntile; ++t) {
        LAS unsigned char* stg = lds + IDX_STAGE + (t & 1) * 8192;
        *(LAS u32x4*)(stg + sdst) = pre;
        __syncthreads();
        { const int k2 = (t + 1) * 64 + skey; pre = (t + 1 < ntile && k2 < S) ? *(const u32x4*)(KI + (size_t)k2 * 64 + schunk * 8) : (u32x4){0u, 0u, 0u, 0u}; }
        if (cnt0 > CAP - 64) { const unsigned T = wave_select256(bufw, cnt0, hist, lane); cnt0 = TOPK; if (h == 0) tauA = T; }
        if (cnt1 > CAP - 64) { const unsigned T = wave_select256(bufw + CAP, cnt1, hist, lane); cnt1 = TOPK; if (h == 1) tauA = T; }
        if (cnt2 > CAP - 64) { const unsigned T = wave_select256(bufw + 2 * CAP, cnt2, hist, lane); cnt2 = TOPK; if (h == 0) tauB = T; }
        if (cnt3 > CAP - 64) { const unsigned T = wave_select256(bufw + 3 * CAP, cnt3, hist, lane); cnt3 = TOPK; if (h == 1) tauB = T; }
#pragma unroll
        for (int sub = 0; sub < 2; ++sub) {
            const int key = sub * 32 + rho;
            f32x16 acc = {0.f, 0.f, 0.f, 0.f, 0.f, 0.f, 0.f, 0.f, 0.f, 0.f, 0.f, 0.f, 0.f, 0.f, 0.f, 0.f};
#pragma unroll
            for (int s = 0; s < 4; ++s) { const bf16x8 b = *(const LAS bf16x8*)(stg + key * 128 + (((2 * s + h) ^ ((key >> 1) & 7)) << 4));
                acc = __builtin_amdgcn_mfma_f32_32x32x16_bf16(a[s], b, acc, 0, 0, 0); }
            float sa = 0.f, sb = 0.f;
#pragma unroll
            for (int j = 0; j < 8; ++j) { sa += wa[j] * fmaxf(acc[j], 0.f); sb += wb[j] * fmaxf(acc[8 + j], 0.f); }
            sa += 0.f; sb += 0.f;
            const int kidx = t * 64 + key;
            const unsigned ua = __float_as_uint(sa), ub = __float_as_uint(sb);
            const unsigned ma = (ua & 0x80000000u) ? ~ua : (ua | 0x80000000u), mbk = (ub & 0x80000000u) ? ~ub : (ub | 0x80000000u);
            const unsigned pa = (ma & 0xFFFFE000u) | (unsigned)(8191 - kidx), pb = (mbk & 0xFFFFE000u) | (unsigned)(8191 - kidx);
            const bool okA = (kidx < S) && (pa > tauA), okB = (kidx < S) && (pb > tauB);
            const unsigned long long mA = __builtin_amdgcn_ballot_w64(okA), mB = __builtin_amdgcn_ballot_w64(okB);
            const unsigned mAl = (unsigned)mA, mAh = (unsigned)(mA >> 32), mBl = (unsigned)mB, mBh = (unsigned)(mB >> 32);
            const int preA = h ? __builtin_amdgcn_mbcnt_hi(mAh, 0u) : __builtin_amdgcn_mbcnt_lo(mAl, 0u);
            const int preB = h ? __builtin_amdgcn_mbcnt_hi(mBh, 0u) : __builtin_amdgcn_mbcnt_lo(mBl, 0u);
            if (okA) bufA[(h ? cnt1 : cnt0) + preA] = pa;
            if (okB) bufB[(h ? cnt3 : cnt2) + preB] = pb;
            cnt0 += __builtin_popcount(mAl); cnt1 += __builtin_popcount(mAh); cnt2 += __builtin_popcount(mBl); cnt3 += __builtin_popcount(mBh);
        }
    }
    asm volatile("s_waitcnt lgkmcnt(0)" ::: "memory");
#pragma unroll
    for (int q = 0; q < 4; ++q) {
        const int c = (q == 0) ? cnt0 : (q == 1) ? cnt1 : (q == 2) ? cnt2 : cnt3;
        LAS unsigned* bq = bufw + q * CAP;
        if (c > TOPK) (void)wave_select256(bq, c, hist, lane);
        unsigned short* o = SEL + (size_t)(row0 + wave * 4 + q) * 256;
#pragma unroll
        for (int i = 0; i < 4; ++i) o[i * 64 + lane] = (unsigned short)(8191u - (bq[i * 64 + lane] & 8191u));
    }
    __syncthreads();
}
__device__ __forceinline__ void phase_indexer(const Args& A, LAS unsigned char* lds, int blk, int G) {
    unsigned char* ws = A.ws;
    const bf16_t* QI = (const bf16_t*)(ws + WS_QIB); const float* WI = (const float*)(ws + WS_WIF); unsigned short* SEL = (unsigned short*)(ws + WS_SEL);
    for (int round = 0;; ++round) {
        const int pos = round * G + ((round & 1) ? (G - 1 - blk) : blk);
        if (round * G >= 504) break;
        if (pos >= 504) continue;
        if (pos >= 256 && pos < 264) { const int b = pos - 256;
            indexer_unit(lds, QI, WI, MP + b * 32, (const bf16_t*)(ws + WS_KIS) + (size_t)b * SKS * 64, SKS, SEL);
        } else { const int v = (pos < 256) ? pos : pos - 264; const int c = (pos < 256) ? 127 - (v >> 2) : 63 - (v >> 2); const int b = (v >> 1) & 1, half = v & 1;
            indexer_unit(lds, QI, WI, b * SEQ + c * 64 + half * 32, (const bf16_t*)(ws + WS_KIP) + (size_t)b * SEQ * 64, 64 * (c + 1), SEL);
        }
    }
}
__device__ __forceinline__ void phase_conv(const Args& A, int blk, int G) {
    unsigned char* ws = A.ws;
    const bf16_t* U = (const bf16_t*)(ws + WS_U); const bf16_t* BG = (const bf16_t*)(ws + WS_BG); bf16_t* Y = (bf16_t*)(ws + WS_YCAT);
    const float* cw = A.in[15]; const float* cc = A.in[2];
    const int tid = fresh_tid(), ch = (tid & 63) * 8, rsub = tid >> 6;
    float w0[8], w1[8], w2[8];
#pragma unroll
    for (int e = 0; e < 8; ++e) { w0[e] = cw[ch + e]; w1[e] = cw[512 + ch + e]; w2[e] = cw[1024 + ch + e]; }
    for (int row = blk * 8 + rsub; row < M; row += G * 8) {
        int t, b; const bool samp = row >= MP; if (samp) { t = (row - MP) & 31; b = (row - MP) >> 5; } else { t = row & (SEQ - 1); b = row >> 13; }
        float u0[8], u1[8], u2[8], bg[8];
        { const u32x4 x = *(const u32x4*)(U + (size_t)row * 512 + ch); const u32x4 g = *(const u32x4*)(BG + (size_t)row * 512 + ch);
#pragma unroll
          for (int e = 0; e < 4; ++e) { u2[2 * e] = __uint_as_float(x[e] << 16); u2[2 * e + 1] = __uint_as_float(x[e] & 0xFFFF0000u); bg[2 * e] = __uint_as_float(g[e] << 16); bg[2 * e + 1] = __uint_as_float(g[e] & 0xFFFF0000u); } }
        if (t >= 1) { const u32x4 x = *(const u32x4*)(U + (size_t)(row - 1) * 512 + ch);
#pragma unroll
            for (int e = 0; e < 4; ++e) { u1[2 * e] = __uint_as_float(x[e] << 16); u1[2 * e + 1] = __uint_as_float(x[e] & 0xFFFF0000u); } }
        else {
#pragma unroll
            for (int e = 0; e < 8; ++e) u1[e] = samp ? cc[(size_t)(b * 2 + 1) * 512 + ch + e] : 0.f; }
        if (t >= 2) { const u32x4 x = *(const u32x4*)(U + (size_t)(row - 2) * 512 + ch);
#pragma unroll
            for (int e = 0; e < 4; ++e) { u0[2 * e] = __uint_as_float(x[e] << 16); u0[2 * e + 1] = __uint_as_float(x[e] & 0xFFFF0000u); } }
        else {
#pragma unroll
            for (int e = 0; e < 8; ++e) u0[e] = samp ? cc[(size_t)(b * 2 + t) * 512 + ch + e] : 0.f; }
        float y[8];
#pragma unroll
        for (int e = 0; e < 8; ++e) y[e] = bg[e] * (w0[e] * u0[e] + w1[e] * u1[e] + w2[e] * u2[e]);
        u32x4 o; o.x = cvtpk(y[0], y[1]); o.y = cvtpk(y[2], y[3]); o.z = cvtpk(y[4], y[5]); o.w = cvtpk(y[6], y[7]);
        *(u32x4*)(Y + (size_t)row * D + ch) = o;
    }
}

constexpr int AT_VPITCH = 288, AT_WAVE_BYTES = 32 * AT_VPITCH + 512;
static_assert(8 * AT_WAVE_BYTES <= LDS_BYTES, "attention LDS");
__device__ __forceinline__ void phase_attn(const Args& A, LAS unsigned char* lds, int vcu, int G) {
    unsigned char* ws = A.ws;
    const int tid = fresh_tid(), lane = tid & 63, wave = __builtin_amdgcn_readfirstlane(tid >> 6), n = lane & 15, g = lane >> 4;
    LAS unsigned char* vl = lds + wave * AT_WAVE_BYTES;
    LAS unsigned short* il = (LAS unsigned short*)(vl + 32 * AT_VPITCH);
    const bf16_t* QB = (const bf16_t*)(ws + WS_QB); const unsigned short* SEL = (const unsigned short*)(ws + WS_SEL); bf16_t* Y = (bf16_t*)(ws + WS_YCAT);
    const int gw = vcu * NWAVES + wave, NGW = G * NWAVES;
    for (int row = gw; row < M; row += NGW) {
        const bf16_t* Kb; const bf16_t* Vb; int nkeys; bool use_sel;
        if (row < MP) { const int b = row >> 13, c = (row & (SEQ - 1)) >> 6; Kb = (const bf16_t*)(ws + WS_KP) + (size_t)b * SEQ * 128; Vb = (const bf16_t*)(ws + WS_VP) + (size_t)b * SEQ * 128;
            use_sel = c >= 4; nkeys = use_sel ? 256 : 64 * (c + 1); }
        else { const int b = (row - MP) >> 5; Kb = (const bf16_t*)(ws + WS_KS) + (size_t)b * SKS * 128; Vb = (const bf16_t*)(ws + WS_VS) + (size_t)b * SKS * 128; use_sel = true; nkeys = 256; }
        { u32x2 w;
          if (use_sel) w = *(const u32x2*)(SEL + (size_t)row * 256 + lane * 4);
          else { const int j0 = lane * 4; const int i0 = j0 < nkeys ? j0 : 0, i1 = j0 + 1 < nkeys ? j0 + 1 : 0, i2 = j0 + 2 < nkeys ? j0 + 2 : 0, i3 = j0 + 3 < nkeys ? j0 + 3 : 0; w.x = (unsigned)i0 | ((unsigned)i1 << 16); w.y = (unsigned)i2 | ((unsigned)i3 << 16); }
          *(LAS u32x2*)(il + lane * 4) = w; }
        bf16x8 bq[4];
#pragma unroll
        for (int s = 0; s < 4; ++s) { bq[s] = (bf16x8){0, 0, 0, 0, 0, 0, 0, 0}; if (n < 8 && (n >> 2) == (s >> 1)) bq[s] = *(const bf16x8*)(QB + (size_t)row * 512 + n * 64 + 32 * (s & 1) + 8 * g); }
        asm volatile("s_waitcnt lgkmcnt(0)" ::: "memory");
        f32x4 sc[16];
#pragma unroll
        for (int i = 0; i < 16; ++i) {
            const int kidx = il[16 * i + n];
            const bf16_t* kr = Kb + (size_t)kidx * 128 + 8 * g;
            f32x4 acc = {0.f, 0.f, 0.f, 0.f};
#pragma unroll
            for (int s = 0; s < 4; ++s) { const bf16x8 ka = *(const bf16x8*)(kr + 32 * s); acc = __builtin_amdgcn_mfma_f32_16x16x32_bf16(ka, bq[s], acc, 0, 0, 0); }
            sc[i] = acc;
            if (i & 1) __builtin_amdgcn_sched_barrier(0);
        }
        const float cs = 0.125f * 1.4426950408889634f;
        float mx = -INFINITY;
#pragma unroll
        for (int i = 0; i < 16; ++i)
#pragma unroll
            for (int r = 0; r < 4; ++r) { const bool valid = (16 * i + 4 * g + r) < nkeys; sc[i][r] = valid ? sc[i][r] : -INFINITY; mx = fmaxf(mx, sc[i][r]); }
        mx = fmaxf(mx, __shfl_xor(mx, 16)); mx = fmaxf(mx, __shfl_xor(mx, 32));
        float ls = 0.f;
#pragma unroll
        for (int i = 0; i < 16; ++i)
#pragma unroll
            for (int r = 0; r < 4; ++r) { const float p = __builtin_amdgcn_exp2f((sc[i][r] - mx) * cs); sc[i][r] = p; ls += p; }
        ls += __shfl_xor(ls, 16); ls += __shfl_xor(ls, 32);
        f32x4 o[8];
#pragma unroll
        for (int nt = 0; nt < 8; ++nt) o[nt] = (f32x4){0.f, 0.f, 0.f, 0.f};
#pragma unroll
        for (int c8 = 0; c8 < 8; ++c8) {
            u32x4 vr[8];
#pragma unroll
            for (int i = 0; i < 8; ++i) { const int lr = 4 * i + g; const int kidx = il[32 * c8 + lr]; vr[i] = *(const u32x4*)(Vb + (size_t)kidx * 128 + n * 8); }
#pragma unroll
            for (int i = 0; i < 8; ++i) *(LAS u32x4*)(vl + (4 * i + g) * AT_VPITCH + n * 16) = vr[i];
            bf16x8 pa; { u32x4 w; w.x = cvtpk(sc[2 * c8][0], sc[2 * c8][1]); w.y = cvtpk(sc[2 * c8][2], sc[2 * c8][3]); w.z = cvtpk(sc[2 * c8 + 1][0], sc[2 * c8 + 1][1]); w.w = cvtpk(sc[2 * c8 + 1][2], sc[2 * c8 + 1][3]); pa = __builtin_bit_cast(bf16x8, w); }
            LAS unsigned char* tb = vl + (4 * g + (n >> 2)) * AT_VPITCH + (n & 3) * 8;
#pragma unroll
            for (int nt = 0; nt < 8; ++nt) {
                const s16x4 lo = __builtin_bit_cast(s16x4, __builtin_amdgcn_ds_read_tr16_b64_v4i16((LAS s16x4*)(tb + nt * 32)));
                const s16x4 hi = __builtin_bit_cast(s16x4, __builtin_amdgcn_ds_read_tr16_b64_v4i16((LAS s16x4*)(tb + 16 * AT_VPITCH + nt * 32)));
                const bf16x8 vb = (bf16x8){lo[0], lo[1], lo[2], lo[3], hi[0], hi[1], hi[2], hi[3]};
                o[nt] = __builtin_amdgcn_mfma_f32_16x16x32_bf16(pa, vb, o[nt], 0, 0, 0);
            }
            asm volatile("s_waitcnt lgkmcnt(0)" ::: "memory");
            __builtin_amdgcn_sched_barrier(0);
        }
#pragma unroll
        for (int r = 0; r < 4; ++r) { const float inv = 1.f / __shfl(ls, 4 * (g & 1) + r);
            if (g < 2) {
#pragma unroll
                for (int j = 0; j < 4; ++j) { const float val = (g == 0 ? o[j][r] : o[4 + j][r]) * inv; const unsigned w = cvtpk(val, val);
                    Y[(size_t)row * D + 512 + (4 * g + r) * 64 + 16 * j + n] = (bf16_t)(w & 0xFFFFu); } } }
    }
}

constexpr int N_PHASES = 18;
template <int PH_LO, int PH_HI>
__global__ void __launch_bounds__(NWAVES * 64, 2) fwd_kernel(Args args) {
    extern __shared__ __attribute__((aligned(16))) unsigned char lds_raw[];
    LAS unsigned char* lds = (LAS unsigned char*)lds_raw;
    const int tid = threadIdx.x;
    const int G = gridDim.x, bx = blockIdx.x;
    const int vcu = (G % 8 == 0) ? (bx % 8) * (G / 8) + bx / 8 : bx;
    unsigned char* ws = args.ws; float* out = args.out;
    volatile LAS unsigned* MISC = (volatile LAS unsigned*)(lds + LDS_BYTES - 64);
    if (tid < 16) MISC[tid] = 0u;
    __syncthreads();
    unsigned* ctl = (unsigned*)(ws + WS_CTL);
    XcdBarrier bar; bar.bar = ctl + 4096; bar.x = 0; bar.st = nullptr;
    constexpr bool one_launch = (PH_HI - PH_LO) > 1;
    if constexpr (one_launch) bar = xcd_barrier_post(ctl + 4096, MISC + 8);
#define IN(k) (PH_LO <= (k) && (k) < PH_HI)
#define SEAM(k) do { if constexpr (IN(k) && IN((k) + 1)) xcd_barrier(bar); } while (0)
    bf16_t* XB = (bf16_t*)(ws + WS_XB); float* X32 = out + O_Y;

    if constexpr (IN(0)) { phase_prologue(args, lds, vcu, G); } SEAM(0);
    if constexpr (IN(1)) {
        { pg8::Gemm g{D, D, D}; pg8::StaticOrder S; S.init(XB, ws + WS_WGU1, D, D, M, NGU, G, bx); EpiGateUp E{(bf16_t*)(ws + WS_HB)};
          pg8::gemm_phase<EpiGateUp, pg8::StaticOrder, true, true>(lds, g, S, E); }
        if (bx >= G - 16) { const int j = bx - (G - 16); pg8::OneUnit S; S.u0.pm = j >> 3; S.u0.pn = j & 3; S.u0.aux = (j >> 2) & 1;
            S.u0.a = (const char*)(ws + WS_MEMPB) + (size_t)S.u0.pm * 256 * D * 2; S.u0.b = (const char*)(ws + (S.u0.aux ? WS_WV : WS_WK)) + (size_t)S.u0.pn * 256 * D * 2;
            pg8::Gemm g{D, D, D}; EpiMemKV E{out + O_MKP, out + O_MVP};
            pg8::gemm_phase<EpiMemKV, pg8::OneUnit, true, true>(lds, g, S, E); }
    } SEAM(1);
    if constexpr (IN(2)) {
        pg8::Gemm g{FF, FF, FF}; pg8::StaticOrder S; S.init(ws + WS_HB, ws + WS_WD1, FF, FF, M, D, G, bx); EpiResid E{args.in[0], args.in[1], X32, 0.5f};
        pg8::gemm_phase<EpiResid, pg8::StaticOrder, true, true>(lds, g, S, E);
        phase_memconv(args, lds, vcu, G);
    } SEAM(2);
    if constexpr (IN(3)) { phase_ln(X32, XB, args.in[12], args.in[13], vcu, G); } SEAM(3);
    if constexpr (IN(4)) {
        pg8::Gemm g{D, D, D}; pg8::StaticOrder S; S.init(XB, ws + WS_WMIX, D, D, M, NMIX, G, bx); EpiMixIn E{out, ws};
        pg8::gemm_phase<EpiMixIn, pg8::StaticOrder, true, true>(lds, g, S, E);
    } SEAM(4);
    if constexpr (IN(5)) { phase_indexer(args, lds, bx, G); phase_conv(args, bx, G); } SEAM(5);
    if constexpr (IN(6)) { phase_attn(args, lds, vcu, G); } SEAM(6);
    if constexpr (IN(7)) {
        pg8::Gemm g{D, D, D}; pg8::StaticOrder S; S.init(ws + WS_YCAT, ws + WS_WMO, D, D, M, D, G, bx); EpiResid E{X32, X32 + (size_t)MP * D, X32, 1.0f};
        pg8::gemm_phase<EpiResid, pg8::StaticOrder, true, true>(lds, g, S, E);
    } SEAM(7);
    if constexpr (IN(8)) { phase_ln(X32, XB, args.in[17], args.in[18], vcu, G); } SEAM(8);
    if constexpr (IN(9)) {
        pg8::Gemm g{D, D, D}; pg8::StaticOrder S; S.init(XB, ws + WS_WQ, D, D, M, D, G, bx); EpiBf16 E{(bf16_t*)(ws + WS_QM), D};
        pg8::gemm_phase<EpiBf16, pg8::StaticOrder, true, true>(lds, g, S, E);
    } SEAM(9);
    if constexpr (IN(10)) {
        MemOrder MO{(const char*)(ws + WS_QM), (const char*)(ws + WS_MK), G, bx};
        for (int i = 0;; ++i) { pg8::OneUnit S; if (!MO.next(i, S.u0)) break; pg8::Gemm g{D, D, 256}; EpiSoftmaxP E{(bf16_t*)(ws + WS_PM)};
            pg8::gemm_phase<EpiSoftmaxP, pg8::OneUnit, false, true>(lds, g, S, E); }
    } SEAM(10);
    if constexpr (IN(11)) {
        MemOrder MO{(const char*)(ws + WS_PM), (const char*)(ws + WS_MVT), G, bx}; pg8::Gemm g{D, D, 256}; EpiBf16Filt E{(bf16_t*)(ws + WS_OM)};
        pg8::gemm_phase<EpiBf16Filt, MemOrder, true, true>(lds, g, MO, E);
    } SEAM(11);
    if constexpr (IN(12)) {
        pg8::Gemm g{D, D, D}; pg8::StaticOrder S; S.init(ws + WS_OM, ws + WS_WO, D, D, M, D, G, bx); EpiResid E{X32, X32 + (size_t)MP * D, X32, 1.0f};
        pg8::gemm_phase<EpiResid, pg8::StaticOrder, true, true>(lds, g, S, E);
    } SEAM(12);
    if constexpr (IN(13)) { phase_ln(X32, XB, args.in[23], args.in[24], vcu, G); } SEAM(13);
    if constexpr (IN(14)) {
        pg8::Gemm g{D, D, D}; pg8::StaticOrder S; S.init(XB, ws + WS_WGU2, D, D, M, NGU, G, bx); EpiGateUp E{(bf16_t*)(ws + WS_HB)};
        pg8::gemm_phase<EpiGateUp, pg8::StaticOrder, true, true>(lds, g, S, E);
    } SEAM(14);
    if constexpr (IN(15)) {
        pg8::Gemm g{FF, FF, FF}; pg8::StaticOrder S; S.init(ws + WS_HB, ws + WS_WD2, FF, FF, M, D, G, bx); EpiResid E{X32, X32 + (size_t)MP * D, X32, 0.5f};
        pg8::gemm_phase<EpiResid, pg8::StaticOrder, true, true>(lds, g, S, E);
    } SEAM(15);
    if constexpr (IN(16)) { phase_ln(X32, XB, args.in[28], args.in[29], vcu, G); }
#undef IN
#undef SEAM
}

#include <utility>
template <int LO, int HI> static bool set_attr1() { auto kp = &fwd_kernel<LO, HI>; return hipFuncSetAttribute((const void*)kp, hipFuncAttributeMaxDynamicSharedMemorySize, LDS_BYTES) == hipSuccess; }
template <int LO, int HI> static void launch1(int grid, hipStream_t stream, const Args& a) { auto kp = &fwd_kernel<LO, HI>; hipLaunchKernelGGL(kp, dim3(grid), dim3(NWAVES * 64), LDS_BYTES, stream, a); }
#if MK_N_LAUNCHES == 1
static bool set_attrs() { return set_attr1<0, 17>(); }
#else
template <int... P> static bool set_attrs_t(std::integer_sequence<int, P...>) { bool ok = true; ((ok = set_attr1<P, P + 1>() && ok), ...); return ok; }
static bool set_attrs() { return set_attrs_t(std::make_integer_sequence<int, 17>{}); }
template <int... P> static void launch_all(int grid, hipStream_t stream, const Args& a, std::integer_sequence<int, P...>) { (launch1<P, P + 1>(grid, stream, a), ...); }
#endif
extern "C" void kernel_launch(void* const* d_in, const int* in_sizes, int n_in, void* d_out, int out_size, void* d_ws, size_t ws_size, hipStream_t stream) {
    static int grid = 0;
    if (grid == 0) {
        if (n_in != 30 || (size_t)out_size != O_END || ws_size < WS_END) { fprintf(stderr, "kernel_launch: unexpected shapes: n_in %d out %d (want %zu) ws %zu (want %zu)\n", n_in, out_size, (size_t)O_END, ws_size, (size_t)WS_END); grid = -1; return; }
        int dev = 0, cus = 0;
        if (hipGetDevice(&dev) != hipSuccess || hipDeviceGetAttribute(&cus, hipDeviceAttributeMultiprocessorCount, dev) != hipSuccess) { grid = -1; return; }
        if (!set_attrs()) { fprintf(stderr, "kernel_launch: hipFuncSetAttribute failed\n"); grid = -1; return; }
        (void)hipGetLastError();
        grid = cus > 256 ? 256 : cus;
    }
    if (grid < 0) return;
    (void)hipMemsetAsync((char*)d_ws + WS_CTL, 0, CTL_BYTES, stream);
    Args a{};
    for (int i = 0; i < 30; ++i) a.in[i] = (const float*)d_in[i];
    a.out = (float*)d_out; a.ws = (unsigned char*)d_ws;
#if MK_N_LAUNCHES == 1
    launch1<0, 17>(grid, stream, a);
#else
    launch_all(grid, stream, a, std::make_integer_sequence<int, 17>{});
#endif
}
```

```cpp
#include <hip/hip_runtime.h>
#include <cstdio>
#include <cstdint>
#include <cstddef>

#ifndef MK_N_LAUNCHES
#define MK_N_LAUNCHES 1
#endif

#ifndef REPEAT_MASK
#define REPEAT_MASK 0
#endif
#define LAS __attribute__((address_space(3)))
typedef unsigned short bf16_t;
typedef short bf16x8 __attribute__((ext_vector_type(8)));
typedef short s16x4 __attribute__((ext_vector_type(4)));
typedef float f32x4 __attribute__((ext_vector_type(4)));
typedef float f32x2 __attribute__((ext_vector_type(2)));
typedef float f32x16 __attribute__((ext_vector_type(16)));
typedef unsigned u32x4 __attribute__((ext_vector_type(4)));
typedef unsigned u32x2 __attribute__((ext_vector_type(2)));
typedef __bf16 bf16x2_t __attribute__((ext_vector_type(2)));

constexpr int D = 1024, SEQ = 8192, NBATCH = 2, MP = NBATCH * SEQ;
constexpr int DEC_B = 8, DEC_T = 32, MS = DEC_B * DEC_T, PAST = 4096;
constexpr int M = MP + MS;
constexpr int FF = 2816, NGU = 2 * FF;
constexpr int DCONV = 512, NMIX = 3072, NMIX_SRC = 2888;
constexpr int SKS = PAST + DEC_T;
constexpr int TOPK = 256;
constexpr float ALPHA = 1.189207115002721f;
constexpr float LN_EPS = 1e-5f;
constexpr float WI_SCALE = 0.04419417382415922f;

constexpr size_t O_Y = 0;
constexpr size_t O_CONVP = (size_t)M * D;
constexpr size_t O_KP = O_CONVP + 2 * 2 * DCONV;
constexpr size_t O_VP = O_KP + (size_t)MP * 128;
constexpr size_t O_IKP = O_VP + (size_t)MP * 128;
constexpr size_t O_MKP = O_IKP + (size_t)MP * 64;
constexpr size_t O_MVP = O_MKP + (size_t)2 * 256 * 1024;
constexpr size_t O_CONVS = O_MVP + (size_t)2 * 256 * 1024;
constexpr size_t O_KS = O_CONVS + 8 * 2 * DCONV;
constexpr size_t O_VS = O_KS + (size_t)MS * 128;
constexpr size_t O_IKS = O_VS + (size_t)MS * 128;
constexpr size_t O_END = O_IKS + (size_t)MS * 64;

constexpr size_t WS_CTL = 0, CTL_BYTES = 1u << 20;
constexpr size_t WS_WGU1 = WS_CTL + CTL_BYTES;
constexpr size_t WS_WD1 = WS_WGU1 + (size_t)NGU * D * 2;
constexpr size_t WS_WGU2 = WS_WD1 + (size_t)D * FF * 2;
constexpr size_t WS_WD2 = WS_WGU2 + (size_t)NGU * D * 2;
constexpr size_t WS_WMIX = WS_WD2 + (size_t)D * FF * 2;
constexpr size_t WS_WMO = WS_WMIX + (size_t)NMIX * D * 2;
constexpr size_t WS_WQ = WS_WMO + (size_t)D * D * 2;
constexpr size_t WS_WK = WS_WQ + (size_t)D * D * 2;
constexpr size_t WS_WV = WS_WK + (size_t)D * D * 2;
constexpr size_t WS_WO = WS_WV + (size_t)D * D * 2;
constexpr size_t WS_XB = WS_WO + (size_t)D * D * 2;
constexpr size_t WS_MEMPB = WS_XB + (size_t)M * D * 2;
constexpr size_t WS_KS = WS_MEMPB + (size_t)512 * D * 2;
constexpr size_t WS_VS = WS_KS + (size_t)DEC_B * SKS * 128 * 2;
constexpr size_t WS_KIS = WS_VS + (size_t)DEC_B * SKS * 128 * 2;
constexpr size_t WS_MK = WS_KIS + (size_t)DEC_B * SKS * 64 * 2;
constexpr size_t WS_MVT = WS_MK + (size_t)10 * 4 * 65536 * 2;
constexpr size_t WS_OV = WS_MVT + (size_t)10 * 4 * 65536 * 2;
constexpr size_t WS_HB = WS_OV;
constexpr size_t WS_U = WS_OV;
constexpr size_t WS_BG = WS_U + (size_t)M * 512 * 2;
constexpr size_t WS_QB = WS_BG + (size_t)M * 512 * 2;
constexpr size_t WS_QIB = WS_QB + (size_t)M * 512 * 2;
constexpr size_t WS_KP = WS_QIB + (size_t)M * 512 * 2;
constexpr size_t WS_VP = WS_KP + (size_t)MP * 128 * 2;
constexpr size_t WS_KIP = WS_VP + (size_t)MP * 128 * 2;
constexpr size_t WS_WIF = WS_KIP + (size_t)MP * 64 * 2;
constexpr size_t WS_SEL = WS_WIF + (size_t)M * 8 * 4;
constexpr size_t WS_YCAT = WS_SEL + (size_t)M * 256 * 2;
constexpr size_t WS_OVB_END = WS_YCAT + (size_t)M * D * 2;
constexpr size_t WS_QM = WS_OV;
constexpr size_t WS_PM = WS_QM + (size_t)M * D * 2;
constexpr size_t WS_OM = WS_PM + (size_t)M * D * 2;
constexpr size_t WS_OVC_END = WS_OM + (size_t)M * D * 2;
constexpr size_t WS_OVA_END = WS_HB + (size_t)M * FF * 2;
constexpr size_t cmax(size_t a, size_t b) { return a > b ? a : b; }
constexpr size_t WS_END = cmax(WS_OVA_END, cmax(WS_OVB_END, WS_OVC_END));
static_assert(WS_END <= 268435456ull, "d_ws map exceeds 256 MiB");
static_assert(WS_OV % 256 == 0 && WS_KP % 256 == 0 && WS_SEL % 256 == 0, "alignment");

constexpr int LDS_BYTES = 163840;
constexpr int NWAVES = 8;

__device__ __forceinline__ unsigned cvtpk(float lo, float hi) { f32x2 v = {lo, hi}; bf16x2_t b = __builtin_convertvector(v, bf16x2_t); return __builtin_bit_cast(unsigned, b); }
__device__ __forceinline__ int fresh_tid(int wave0) {
    int l; asm volatile("v_mbcnt_lo_u32_b32 %0, -1, 0\n\tv_mbcnt_hi_u32_b32 %0, -1, %0" : "=v"(l)); return (wave0 << 6) | l; }
__device__ __forceinline__ float bf2f(unsigned short h) { return __uint_as_float((unsigned)h << 16); }

namespace pg8 {
constexpr int BM = 256, BK = 64, HALF = 128, HTB = HALF * BK * 2, STAGE_BYTES = 8 * HTB, NXCD = 8, WGM = 8;
__host__ __device__ __forceinline__ int lds_byte(int r, int c) { const int st = (r >> 4) * 2 + (c >> 5), rr = r & 15, cc = c & 31, ob = rr * 64 + cc * 2; return st * 1024 + (ob ^ (((ob >> 9) & 1) << 5)); }
__host__ __device__ __forceinline__ void stage_rc(int b, int& R, int& C) { const int st = b / 1024, sb = b % 1024, swz = sb ^ (((sb >> 9) & 1) << 5); R = (st >> 1) * 16 + swz / 64; C = (st & 1) * 32 + (swz % 64) / 2; }

struct Unit { int pm, pn, aux; const char* a; const char* b; };
struct Gemm { int lda, ldb, K; };

struct StaticOrder {
    int nM, nN, nwg, G, c; const char* A; const char* Bt; size_t sa, sb;
    __device__ __forceinline__ void init(const void* A_, const void* Bt_, int lda, int ldb, int M_, int N_, int G_, int c_) { nM = M_ / BM; nN = N_ / BM; nwg = nM * nN; G = G_; c = c_; A = (const char*)A_; Bt = (const char*)Bt_; sa = (size_t)BM * lda * 2; sb = (size_t)BM * ldb * 2; }
    __device__ __forceinline__ bool next(int i, Unit& u) const {
        const long L = (long)i * G + c; if (L >= nwg) return false;
        int wgid = (int)L; { const int q = nwg / NXCD, r = nwg % NXCD, xcd = wgid % NXCD, off = wgid / NXCD; wgid = (xcd < r ? xcd * (q + 1) : r * (q + 1) + (xcd - r) * q) + off; }
        const int nig = WGM * nN, gid = wgid / nig, fm = gid * WGM, gsz = (nM - fm) < WGM ? (nM - fm) : WGM;
        u.pm = fm + ((wgid % nig) % gsz); u.pn = (wgid % nig) / gsz; u.aux = 0; u.a = A + (size_t)u.pm * sa; u.b = Bt + (size_t)u.pn * sb; return true;
    }
};
struct OneUnit { Unit u0; __device__ __forceinline__ bool next(int i, Unit& u) const { if (i) return false; u = u0; return true; } };

template <class Epi, class Sched, bool ALIGN_EPI, bool SP2>
__device__ __forceinline__ void gemm_phase(LAS unsigned char* lds, const Gemm g, const Sched& S, const Epi& E, int wave0) {
    const int tid = fresh_tid(wave0), wid = __builtin_amdgcn_readfirstlane(tid >> 6), lane = tid & 63, wr = wid >> 2, wc = wid & 3, fr = lane & 15, fq = lane >> 4;
    const int K = g.K, nt = K / BK;
    unsigned voffA[2], voffB[2];
#pragma unroll
    for (int i = 0; i < 2; ++i) { int R, C; stage_rc(tid * 16 + i * 8192, R, C); voffA[i] = (unsigned)(R * g.lda + C) * 2u; voffB[i] = (unsigned)(R * g.ldb + C) * 2u; }
    const size_t kstep = (size_t)(BK * 2);
    const size_t hstepA = (size_t)HALF * g.lda * 2, hstepB = (size_t)HALF * g.ldb * 2;
    const unsigned ldsw = (unsigned)wid * 1024u;
    const int aoff = lds_byte(wr * 64 + fr, fq * 8), boff = lds_byte(wc * 32 + fr, fq * 8);
#define PG8_SA(b, h) (((b) * 2 + (h)) * HTB)
#define PG8_SB(b, h) ((4 + (b) * 2 + (h)) * HTB)
#define PG8_STAGE(bufoff, gbase, voff) do { _Pragma("unroll") for (int _i = 0; _i < 2; ++_i) \
        __builtin_amdgcn_global_load_lds((const unsigned*)((const char*)(gbase) + (voff)[_i]), (LAS unsigned*)(lds + (bufoff) + ldsw + _i * 8192), 16, 0, 0); } while (0)
#define PG8_LDA(dst, b, h) do { _Pragma("unroll") for (int m = 0; m < 4; ++m) _Pragma("unroll") for (int k = 0; k < 2; ++k) dst[m][k] = *(const LAS bf16x8*)(lds + PG8_SA(b, h) + aoff + m * 2048 + k * 1024); } while (0)
#define PG8_LDB(dst, b, h) do { _Pragma("unroll") for (int n = 0; n < 2; ++n) _Pragma("unroll") for (int k = 0; k < 2; ++k) dst[n][k] = *(const LAS bf16x8*)(lds + PG8_SB(b, h) + boff + n * 2048 + k * 1024); } while (0)
#define PG8_MMA(ai, bj, At, Bt) do { __builtin_amdgcn_s_setprio(1); _Pragma("unroll") for (int m = 0; m < 4; ++m) _Pragma("unroll") for (int n = 0; n < 2; ++n) _Pragma("unroll") for (int k = 0; k < 2; ++k) \
        acc[ai][bj][m][n] = __builtin_amdgcn_mfma_f32_16x16x32_bf16(Bt[n][k], At[m][k], acc[ai][bj][m][n], 0, 0, 0); __builtin_amdgcn_s_setprio(0); } while (0)
#define PG8_WAIT_V(n) asm volatile("s_waitcnt vmcnt(" #n ")" ::: "memory")
#define PG8_WAIT_L(n) asm volatile("s_waitcnt lgkmcnt(" #n ")" ::: "memory")
#define PG8_BAR __builtin_amdgcn_s_barrier()
#define PG8_SCHED __builtin_amdgcn_sched_barrier(0)
    Unit cur, nxt; int ui = 0;
    if (!S.next(0, cur)) return;
    f32x4 acc[2][2][4][2];
#pragma unroll
    for (int a = 0; a < 2; ++a)
#pragma unroll
        for (int b = 0; b < 2; ++b)
#pragma unroll
            for (int m = 0; m < 4; ++m)
#pragma unroll
                for (int n = 0; n < 2; ++n) acc[a][b][m][n] = (f32x4){0.f, 0.f, 0.f, 0.f};
    bf16x8 At[4][2], B0[2][2], B1[2][2];
    const char* cA = cur.a; const char* cB = cur.b;
    if constexpr (SP2) {
        PG8_STAGE(PG8_SB(0, 0), cB, voffB); PG8_STAGE(PG8_SB(0, 1), cB + hstepB, voffB); PG8_STAGE(PG8_SA(0, 0), cA, voffA); PG8_STAGE(PG8_SA(0, 1), cA + hstepA, voffA);
        if (wr == 1) PG8_BAR;
        PG8_WAIT_V(2); PG8_BAR;
        PG8_STAGE(PG8_SB(1, 0), cB + kstep, voffB); PG8_STAGE(PG8_SA(1, 0), cA + kstep, voffA); PG8_STAGE(PG8_SB(1, 1), cB + hstepB + kstep, voffB);
        PG8_WAIT_V(6); PG8_BAR;
    } else {
        PG8_STAGE(PG8_SB(0, 0), cB, voffB); PG8_STAGE(PG8_SA(0, 0), cA, voffA); PG8_STAGE(PG8_SB(0, 1), cB + hstepB, voffB); PG8_STAGE(PG8_SA(0, 1), cA + hstepA, voffA);
        if (wr == 1) PG8_BAR;
        PG8_WAIT_V(4); PG8_BAR;
        PG8_STAGE(PG8_SB(1, 0), cB + kstep, voffB); PG8_STAGE(PG8_SA(1, 0), cA + kstep, voffA); PG8_STAGE(PG8_SB(1, 1), cB + hstepB + kstep, voffB);
        PG8_WAIT_V(6); PG8_BAR;
    }
    for (;;) {
        const bool has_next = S.next(ui + 1, nxt);
        const char* nA = has_next ? nxt.a : cA; const char* nB = has_next ? nxt.b : cB;
        for (int t = 0; t < nt; t += 2) {
            const bool last = (t == nt - 2);
            const char* a1 = cA + (size_t)(t + 1) * kstep;
            const char* a2 = last ? nA : cA + (size_t)(t + 2) * kstep; const char* b2 = last ? nB : cB + (size_t)(t + 2) * kstep;
            const char* a3 = a2 + kstep; const char* b3 = b2 + kstep;
            if constexpr (SP2) {
            PG8_LDB(B0, 0, 0); PG8_LDB(B1, 0, 1); PG8_SCHED; PG8_LDA(At, 0, 0); PG8_STAGE(PG8_SA(1, 1), a1 + hstepA, voffA);
            PG8_WAIT_V(8); PG8_WAIT_L(0); PG8_BAR; PG8_MMA(0, 0, At, B0); PG8_MMA(0, 1, At, B1); PG8_BAR; PG8_SCHED;
            PG8_LDA(At, 0, 1); PG8_STAGE(PG8_SB(0, 0), b2, voffB); PG8_STAGE(PG8_SB(0, 1), b2 + hstepB, voffB); PG8_STAGE(PG8_SA(0, 0), a2, voffA);
            PG8_WAIT_V(8); PG8_WAIT_L(0); PG8_BAR; PG8_MMA(1, 0, At, B0); PG8_MMA(1, 1, At, B1); PG8_BAR; PG8_SCHED;
            PG8_LDB(B0, 1, 0); PG8_LDB(B1, 1, 1); PG8_SCHED; PG8_LDA(At, 1, 0); PG8_STAGE(PG8_SA(0, 1), a2 + hstepA, voffA);
            PG8_WAIT_V(8); PG8_WAIT_L(0); PG8_BAR; PG8_MMA(0, 0, At, B0); PG8_MMA(0, 1, At, B1); PG8_BAR; PG8_SCHED;
            PG8_LDA(At, 1, 1); PG8_STAGE(PG8_SB(1, 0), b3, voffB); PG8_STAGE(PG8_SB(1, 1), b3 + hstepB, voffB); PG8_STAGE(PG8_SA(1, 0), a3, voffA);
            PG8_WAIT_V(8); PG8_WAIT_L(0); PG8_BAR; PG8_MMA(1, 0, At, B0); PG8_MMA(1, 1, At, B1); PG8_BAR; PG8_SCHED;
            } else {
            PG8_LDB(B0, 0, 0); PG8_SCHED; PG8_LDA(At, 0, 0); PG8_STAGE(PG8_SA(1, 1), a1 + hstepA, voffA);
            PG8_WAIT_L(8); PG8_BAR; PG8_WAIT_L(0); PG8_MMA(0, 0, At, B0); PG8_BAR; PG8_SCHED;
            PG8_LDB(B1, 0, 1); PG8_STAGE(PG8_SB(0, 0), b2, voffB);
            PG8_BAR; PG8_WAIT_L(0); PG8_MMA(0, 1, At, B1); PG8_BAR;
            PG8_LDA(At, 0, 1); PG8_STAGE(PG8_SA(0, 0), a2, voffA);
            PG8_BAR; PG8_WAIT_L(0); PG8_MMA(1, 0, At, B0); PG8_BAR; PG8_SCHED;
            PG8_STAGE(PG8_SB(0, 1), b2 + hstepB, voffB);
            PG8_WAIT_V(6); PG8_BAR; PG8_MMA(1, 1, At, B1); PG8_BAR;
            PG8_LDB(B0, 1, 0); PG8_SCHED; PG8_LDA(At, 1, 0); PG8_STAGE(PG8_SA(0, 1), a2 + hstepA, voffA);
            PG8_WAIT_L(8); PG8_BAR; PG8_WAIT_L(0); PG8_MMA(0, 0, At, B0); PG8_BAR; PG8_SCHED;
            PG8_LDB(B1, 1, 1); PG8_STAGE(PG8_SB(1, 0), b3, voffB);
            PG8_BAR; PG8_WAIT_L(0); PG8_MMA(0, 1, At, B1); PG8_BAR;
            PG8_LDA(At, 1, 1); PG8_STAGE(PG8_SA(1, 0), a3, voffA);
            PG8_BAR; PG8_WAIT_L(0); PG8_MMA(1, 0, At, B0); PG8_BAR; PG8_SCHED;
            PG8_STAGE(PG8_SB(1, 1), b3 + hstepB, voffB);
            PG8_WAIT_V(6); PG8_BAR; PG8_MMA(1, 1, At, B1); PG8_BAR;
            }
        }
        if constexpr (ALIGN_EPI) { if (wr == 0) PG8_BAR; }
        if constexpr (!Epi::AFTER_DRAIN) { E(acc, cur, wr, wc, fr, fq); }
        if (!has_next) break;
#pragma unroll
        for (int a = 0; a < 2; ++a)
#pragma unroll
            for (int b = 0; b < 2; ++b)
#pragma unroll
                for (int m = 0; m < 4; ++m)
#pragma unroll
                    for (int n = 0; n < 2; ++n) acc[a][b][m][n] = (f32x4){0.f, 0.f, 0.f, 0.f};
        cur = nxt; cA = nA; cB = nB; ++ui;
        if constexpr (ALIGN_EPI) { if (wr == 1) PG8_BAR; }
    }
    PG8_WAIT_V(0);
    if constexpr (!ALIGN_EPI) { if (wr == 0) PG8_BAR; }
    PG8_BAR;
    if constexpr (Epi::AFTER_DRAIN) { E.fused(acc, cur, wr, wc, fr, fq, lds, wid, lane); }
#undef PG8_SA
#undef PG8_SB
#undef PG8_STAGE
#undef PG8_LDA
#undef PG8_LDB
#undef PG8_MMA
#undef PG8_WAIT_V
#undef PG8_WAIT_L
#undef PG8_BAR
#undef PG8_SCHED
}
}

typedef f32x4 Acc[2][2][4][2];
#define EPI_FOR(...) _Pragma("unroll") for (int ai = 0; ai < 2; ++ai) _Pragma("unroll") for (int m = 0; m < 4; ++m) { const int ROW = u.pm * 256 + ai * 128 + wr * 64 + m * 16 + fr; \
    _Pragma("unroll") for (int bj = 0; bj < 2; ++bj) _Pragma("unroll") for (int n = 0; n < 2; ++n) { const int LC = bj * 128 + wc * 32 + n * 16 + fq * 4; const f32x4 V = acc[ai][bj][m][n]; __VA_ARGS__ } }

__device__ __forceinline__ void st_bf16x4(bf16_t* p, f32x4 v) { u32x2 w; w.x = cvtpk(v[0], v[1]); w.y = cvtpk(v[2], v[3]); *(u32x2*)p = w; }

struct EpiGateUp {
    static constexpr bool AFTER_DRAIN = false;
    bf16_t* H;
    __device__ __forceinline__ void operator()(const Acc& acc, const pg8::Unit& u, int wr, int wc, int fr, int fq) const {
#pragma unroll
        for (int ai = 0; ai < 2; ++ai)
#pragma unroll
            for (int m = 0; m < 4; ++m) { const int row = u.pm * 256 + ai * 128 + wr * 64 + m * 16 + fr;
#pragma unroll
                for (int n = 0; n < 2; ++n) { const f32x4 g = acc[ai][0][m][n], up = acc[ai][1][m][n]; f32x4 h;
#pragma unroll
                    for (int e = 0; e < 4; ++e) { const float s = g[e] / (1.f + __expf(-g[e])); h[e] = s * up[e]; }
                    st_bf16x4(H + (size_t)row * FF + u.pn * 128 + wc * 32 + n * 16 + fq * 4, h); } }
    }
};
struct EpiResid {
    static constexpr bool AFTER_DRAIN = false;
    const float* resP; const float* resS; float* X; float scale;
    __device__ __forceinline__ void operator()(const Acc& acc, const pg8::Unit& u, int wr, int wc, int fr, int fq) const {
        EPI_FOR({ const int col = u.pn * 256 + LC; const float* rp = (ROW < MP) ? resP + (size_t)ROW * D + col : resS + (size_t)(ROW - MP) * D + col;
                  const f32x4 r = *(const f32x4*)rp; *(f32x4*)(X + (size_t)ROW * D + col) = r * ALPHA + V * scale; })
    }
};
struct EpiBf16 {
    static constexpr bool AFTER_DRAIN = false;
    bf16_t* O; int ldc;
    __device__ __forceinline__ void operator()(const Acc& acc, const pg8::Unit& u, int wr, int wc, int fr, int fq) const {
        EPI_FOR({ st_bf16x4(O + (size_t)ROW * ldc + u.pn * 256 + LC, V); })
    }
};
struct EpiMemKV {
    static constexpr bool AFTER_DRAIN = false;
    float* outK; float* outV;
    __device__ __forceinline__ void operator()(const Acc& acc, const pg8::Unit& u, int wr, int wc, int fr, int fq) const {
        float* o = u.aux ? outV : outK;
        EPI_FOR({ *(f32x4*)(o + (size_t)ROW * D + u.pn * 256 + LC) = V; })
    }
};
struct EpiMixIn {
    static constexpr bool AFTER_DRAIN = false;
    float* out; unsigned char* ws;
    __device__ __forceinline__ void operator()(const Acc& acc, const pg8::Unit& u, int wr, int wc, int fr, int fq) const {
        const int pn = u.pn; const bool samp = (u.pm == 64);
        if (pn < 4) {
            bf16_t* U = (bf16_t*)(ws + WS_U);
#pragma unroll
            for (int ai = 0; ai < 2; ++ai)
#pragma unroll
                for (int m = 0; m < 4; ++m) { const int row = u.pm * 256 + ai * 128 + wr * 64 + m * 16 + fr;
#pragma unroll
                    for (int n = 0; n < 2; ++n) { const f32x4 uu = acc[ai][0][m][n] * acc[ai][1][m][n]; const int ch = pn * 128 + wc * 32 + n * 16 + fq * 4;
                        st_bf16x4(U + (size_t)row * 512 + ch, uu);
                        if (ai == 1 && m == 3) {
                            if (!samp) { const int t = row & (SEQ - 1); if (t >= SEQ - 2) *(f32x4*)(out + O_CONVP + (size_t)((row >> 13) * 2 + (t - (SEQ - 2))) * DCONV + ch) = uu; } }
                        if (samp && (m & 1)) { const int rs = row - MP, t = rs & 31; if (t >= 30) *(f32x4*)(out + O_CONVS + (size_t)((rs >> 5) * 2 + (t - 30)) * DCONV + ch) = uu; } } }
        } else if (pn == 8) {
#pragma unroll
            for (int bj = 0; bj < 2; ++bj) {
                float* fo = out + (samp ? (bj ? O_VS : O_KS) : (bj ? O_VP : O_KP)) - (samp ? (size_t)MP * 128 : 0);
                bf16_t* bo = (bf16_t*)(ws + (samp ? (bj ? WS_VS : WS_KS) : (bj ? WS_VP : WS_KP)));
#pragma unroll
                for (int ai = 0; ai < 2; ++ai)
#pragma unroll
                    for (int m = 0; m < 4; ++m) { const int row = u.pm * 256 + ai * 128 + wr * 64 + m * 16 + fr; const int rs = row - MP;
                        const size_t brow = samp ? ((size_t)(rs >> 5) * SKS + PAST + (rs & 31)) : (size_t)row;
#pragma unroll
                        for (int n = 0; n < 2; ++n) { const int c = wc * 32 + n * 16 + fq * 4; const f32x4 V = acc[ai][bj][m][n];
                            *(f32x4*)(fo + (size_t)row * 128 + c) = V; st_bf16x4(bo + brow * 128 + c, V); } } }
        } else if (pn == 11) {
            if (wc < 2) {
                float* fo = out + (samp ? O_IKS : O_IKP) - (samp ? (size_t)MP * 64 : 0);
                bf16_t* bo = (bf16_t*)(ws + (samp ? WS_KIS : WS_KIP));
#pragma unroll
                for (int ai = 0; ai < 2; ++ai)
#pragma unroll
                    for (int m = 0; m < 4; ++m) { const int row = u.pm * 256 + ai * 128 + wr * 64 + m * 16 + fr; const int rs = row - MP;
                        const size_t brow = samp ? ((size_t)(rs >> 5) * SKS + PAST + (rs & 31)) : (size_t)row;
#pragma unroll
                        for (int n = 0; n < 2; ++n) { const int c = wc * 32 + n * 16 + fq * 4; const f32x4 V = acc[ai][0][m][n];
                            *(f32x4*)(fo + (size_t)row * 64 + c) = V; st_bf16x4(bo + brow * 64 + c, V); } }
            } else if (wc == 2) {
                float* wf = (float*)(ws + WS_WIF);
#pragma unroll
                for (int ai = 0; ai < 2; ++ai)
#pragma unroll
                    for (int m = 0; m < 4; ++m) { const int row = u.pm * 256 + ai * 128 + wr * 64 + m * 16 + fr;
                        if (fq < 2) *(f32x4*)(wf + (size_t)row * 8 + fq * 4) = acc[ai][0][m][0] * WI_SCALE; }
            }
        } else {
            bf16_t* O = (bf16_t*)(ws + (pn < 6 ? WS_BG : pn < 8 ? WS_QB : WS_QIB)) + ((pn == 5 || pn == 7 || pn == 10) ? 256 : 0);
            EPI_FOR({ st_bf16x4(O + (size_t)ROW * 512 + LC, V); })
        }
    }
};
struct EpiSoftmaxP {
    static constexpr bool AFTER_DRAIN = true;
    bf16_t* P;
    __device__ __forceinline__ void operator()(const Acc&, const pg8::Unit&, int, int, int, int) const {}
    __device__ __forceinline__ void fused(Acc& acc, const pg8::Unit& u, int wr, int wc, int fr, int fq, LAS unsigned char* lds, int wid, int lane) const {
        LAS f32x2* PT = (LAS f32x2*)lds;
        LAS f32x2* ST = (LAS f32x2*)(lds + 8192);
        const float c = 0.0625f * 1.4426950408889634f;
#pragma unroll
        for (int ai = 0; ai < 2; ++ai)
#pragma unroll
            for (int m = 0; m < 4; ++m) {
                float mx = -INFINITY;
#pragma unroll
                for (int bj = 0; bj < 2; ++bj)
#pragma unroll
                    for (int n = 0; n < 2; ++n) { const f32x4 x = acc[ai][bj][m][n]; mx = fmaxf(mx, fmaxf(fmaxf(x[0], x[1]), fmaxf(x[2], x[3]))); }
                mx = fmaxf(mx, __shfl_xor(mx, 16)); mx = fmaxf(mx, __shfl_xor(mx, 32));
                float s = 0.f;
#pragma unroll
                for (int bj = 0; bj < 2; ++bj)
#pragma unroll
                    for (int n = 0; n < 2; ++n) { const f32x4 x = acc[ai][bj][m][n];
#pragma unroll
                        for (int e = 0; e < 4; ++e) s += __builtin_amdgcn_exp2f((x[e] - mx) * c); }
                s += __shfl_xor(s, 16); s += __shfl_xor(s, 32);
                if (fq == 0) PT[(ai * 128 + wr * 64 + m * 16 + fr) * 4 + wc] = (f32x2){mx, s};
            }
        __syncthreads();
        if (wid < 4) { const int row = wid * 64 + lane; const f32x2 a = PT[row * 4], b = PT[row * 4 + 1], cc = PT[row * 4 + 2], d = PT[row * 4 + 3];
            const float mt = fmaxf(fmaxf(a.x, b.x), fmaxf(cc.x, d.x));
            const float l = a.y * __builtin_amdgcn_exp2f((a.x - mt) * c) + b.y * __builtin_amdgcn_exp2f((b.x - mt) * c) + cc.y * __builtin_amdgcn_exp2f((cc.x - mt) * c) + d.y * __builtin_amdgcn_exp2f((d.x - mt) * c);
            ST[row] = (f32x2){mt, 1.f / l}; }
        __syncthreads();
#pragma unroll
        for (int ai = 0; ai < 2; ++ai)
#pragma unroll
            for (int m = 0; m < 4; ++m) { const int rl = ai * 128 + wr * 64 + m * 16 + fr; const f32x2 st = ST[rl]; const int row = u.pm * 256 + rl;
                if (u.aux < 0 || (ai * 4 + wr * 2 + (m >> 1)) == u.aux) {
#pragma unroll
                    for (int bj = 0; bj < 2; ++bj)
#pragma unroll
                        for (int n = 0; n < 2; ++n) { const f32x4 x = acc[ai][bj][m][n]; f32x4 p;
#pragma unroll
                            for (int e = 0; e < 4; ++e) p[e] = __builtin_amdgcn_exp2f((x[e] - st.x) * c) * st.y;
                            st_bf16x4(P + (size_t)row * D + u.pn * 256 + bj * 128 + wc * 32 + n * 16 + fq * 4, p); } } }
        __syncthreads();
    }
};
struct EpiBf16Filt {
    static constexpr bool AFTER_DRAIN = false;
    bf16_t* O;
    __device__ __forceinline__ void operator()(const Acc& acc, const pg8::Unit& u, int wr, int wc, int fr, int fq) const {
#pragma unroll
        for (int ai = 0; ai < 2; ++ai)
#pragma unroll
            for (int m = 0; m < 4; ++m) { if (u.aux >= 0 && (ai * 4 + wr * 2 + (m >> 1)) != u.aux) continue;
                const int row = u.pm * 256 + ai * 128 + wr * 64 + m * 16 + fr;
#pragma unroll
                for (int bj = 0; bj < 2; ++bj)
#pragma unroll
                    for (int n = 0; n < 2; ++n) st_bf16x4(O + (size_t)row * D + u.pn * 256 + bj * 128 + wc * 32 + n * 16 + fq * 4, acc[ai][bj][m][n]); }
    }
};
struct MemOrder {
    const char* A; const char* B; int G, c;
    __device__ __forceinline__ bool get(int L, pg8::Unit& u) const {
        if (L >= 288) return false;
        int pm, h, slot, aux;
        if (L < 256) { pm = L >> 2; h = L & 3; slot = pm >> 5; aux = -1; } else { const int j = L - 256; pm = 64; h = j & 3; aux = j >> 2; slot = 2 + aux; }
        u.pm = pm; u.pn = h; u.aux = aux; u.a = A + ((size_t)pm * 256 * D + h * 256) * 2; u.b = B + ((size_t)slot * 256 * D + h * 256) * 2; return true;
    }
    __device__ __forceinline__ bool next(int i, pg8::Unit& u) const { return get(i * G + c, u); }
};

struct BMap { int row0, seg; };
template <class BM_, class Epi>
__device__ __forceinline__ void sgemm(LAS unsigned char* lds, const bf16_t* A, int lda, const bf16_t* Bt, int ldb, int K, int ntiles, const BM_& bm, const Epi& epi, int blk, int G, int wave0) {
    const int tid = fresh_tid(wave0), lane = tid & 63, w = __builtin_amdgcn_readfirstlane(tid >> 6), fr = lane & 15, fq = lane >> 4;
    const int kw = K >> 3, nks = kw >> 5, k0 = w * kw;
    for (int t = blk; t < ntiles; t += G) {
        const int rt = t & 3, ct = t >> 2; const BMap b = bm(ct);
        f32x4 acc[4][4];
#pragma unroll
        for (int m = 0; m < 4; ++m)
#pragma unroll
            for (int n = 0; n < 4; ++n) acc[m][n] = (f32x4){0.f, 0.f, 0.f, 0.f};
        const bf16_t* ap = A + (size_t)(rt * 64 + fr) * lda + k0 + 8 * fq;
        const bf16_t* bp = Bt + (size_t)(b.row0 + fr) * ldb + k0 + 8 * fq;
        bf16x8 af[4], bfg[4], afn[4], bfn[4];
#pragma unroll
        for (int m = 0; m < 4; ++m) af[m] = *(const bf16x8*)(ap + (size_t)(16 * m) * lda);
#pragma unroll
        for (int n = 0; n < 4; ++n) bfg[n] = *(const bf16x8*)(bp + (size_t)(16 * (n & 1) + (n >> 1) * b.seg) * ldb);
#pragma unroll 1
        for (int ks = 0; ks < nks; ++ks) {
            const int kn = (ks + 1 < nks) ? ks + 1 : ks;
#pragma unroll
            for (int m = 0; m < 4; ++m) afn[m] = *(const bf16x8*)(ap + (size_t)(16 * m) * lda + 32 * kn);
#pragma unroll
            for (int n = 0; n < 4; ++n) bfn[n] = *(const bf16x8*)(bp + (size_t)(16 * (n & 1) + (n >> 1) * b.seg) * ldb + 32 * kn);
#pragma unroll
            for (int m = 0; m < 4; ++m)
#pragma unroll
                for (int n = 0; n < 4; ++n) acc[m][n] = __builtin_amdgcn_mfma_f32_16x16x32_bf16(bfg[n], af[m], acc[m][n], 0, 0, 0);
#pragma unroll
            for (int m = 0; m < 4; ++m) { af[m] = afn[m]; bfg[m] = bfn[m]; }
        }
#pragma unroll
        for (int m = 0; m < 4; ++m)
#pragma unroll
            for (int n = 0; n < 4; ++n) *(LAS f32x4*)(lds + (size_t)(((w * 16 + m * 4 + n) * 64 + lane) * 16)) = acc[m][n];
        __syncthreads();
        { const int m = tid >> 7, n2 = (tid >> 6) & 1, l2 = tid & 63; f32x4 lo = (f32x4){0.f, 0.f, 0.f, 0.f}, hi = lo;
#pragma unroll
          for (int ww = 0; ww < 8; ++ww) { lo += *(const LAS f32x4*)(lds + (size_t)(((ww * 16 + m * 4 + n2) * 64 + l2) * 16)); hi += *(const LAS f32x4*)(lds + (size_t)(((ww * 16 + m * 4 + n2 + 2) * 64 + l2) * 16)); }
          epi(rt * 64 + m * 16 + (l2 & 15), ct, n2 * 16 + (l2 >> 4) * 4, lo, hi); }
        __syncthreads();
    }
}
struct BMapPlain { __device__ __forceinline__ BMap operator()(int ct) const { return BMap{ct * 64, 32}; } };
struct BMapPair { __device__ __forceinline__ BMap operator()(int ct) const { return BMap{(ct >> 2) * 256 + (ct & 3) * 32, 128}; } };
struct BMapMix { __device__ __forceinline__ BMap operator()(int ct) const { return ct < 16 ? BMap{(ct >> 2) * 256 + (ct & 3) * 32, 128} : BMap{1024 + (ct - 16) * 64, 32}; } };
struct SEpiGateUp { bf16_t* H;
    __device__ __forceinline__ void operator()(int rs, int ct, int c, f32x4 g, f32x4 u) const { f32x4 h;
#pragma unroll
        for (int e = 0; e < 4; ++e) h[e] = g[e] / (1.f + __expf(-g[e])) * u[e];
        st_bf16x4(H + (size_t)(MP + rs) * FF + ct * 32 + c, h); } };
struct SEpiResid { const float* res; float* X; float scale;
    __device__ __forceinline__ void operator()(int rs, int ct, int c, f32x4 lo, f32x4 hi) const { const int col = ct * 64 + c;
        const f32x4 r0 = *(const f32x4*)(res + (size_t)rs * D + col), r1 = *(const f32x4*)(res + (size_t)rs * D + col + 32);
        *(f32x4*)(X + (size_t)(MP + rs) * D + col) = r0 * ALPHA + lo * scale; *(f32x4*)(X + (size_t)(MP + rs) * D + col + 32) = r1 * ALPHA + hi * scale; } };
struct SEpiBf16 { bf16_t* O;
    __device__ __forceinline__ void operator()(int rs, int ct, int c, f32x4 lo, f32x4 hi) const { st_bf16x4(O + (size_t)(MP + rs) * D + ct * 64 + c, lo); st_bf16x4(O + (size_t)(MP + rs) * D + ct * 64 + c + 32, hi); } };
struct SEpiMixIn { float* out; unsigned char* ws;
    __device__ __forceinline__ void route(int rs, int ncol, f32x4 v) const { const int row = MP + rs, b = rs >> 5, t = rs & 31, pn = ncol >> 8, LC = ncol & 255;
        if (pn < 6) st_bf16x4((bf16_t*)(ws + WS_BG) + (size_t)row * 512 + (pn - 4) * 256 + LC, v);
        else if (pn < 8) st_bf16x4((bf16_t*)(ws + WS_QB) + (size_t)row * 512 + (pn - 6) * 256 + LC, v);
        else if (pn == 8) { const int isv = LC >> 7, cc = LC & 127; *(f32x4*)(out + (isv ? O_VS : O_KS) + (size_t)rs * 128 + cc) = v; st_bf16x4((bf16_t*)(ws + (isv ? WS_VS : WS_KS)) + ((size_t)b * SKS + PAST + t) * 128 + cc, v); }
        else if (pn < 11) st_bf16x4((bf16_t*)(ws + WS_QIB) + (size_t)row * 512 + (pn - 9) * 256 + LC, v);
        else if (LC < 64) { *(f32x4*)(out + O_IKS + (size_t)rs * 64 + LC) = v; st_bf16x4((bf16_t*)(ws + WS_KIS) + ((size_t)b * SKS + PAST + t) * 64 + LC, v); }
        else if (LC < 72) *(f32x4*)((float*)(ws + WS_WIF) + (size_t)row * 8 + (LC - 64)) = v * WI_SCALE; }
    __device__ __forceinline__ void operator()(int rs, int ct, int c, f32x4 lo, f32x4 hi) const {
        if (ct < 16) { const int ch = (ct >> 2) * 128 + (ct & 3) * 32 + c, t = rs & 31; const f32x4 uu = lo * hi; st_bf16x4((bf16_t*)(ws + WS_U) + (size_t)(MP + rs) * 512 + ch, uu);
            if (t >= 30) *(f32x4*)(out + O_CONVS + (size_t)((rs >> 5) * 2 + (t - 30)) * DCONV + ch) = uu; }
        else { const int ncol = 1024 + (ct - 16) * 64 + c; route(rs, ncol, lo); route(rs, ncol + 32, hi); } } };

#define XB_TMO      128
#define XB_XCNT(j)  (256  + 64 * (j))
#define XB_XSUB(j)  (1280 + 64 * (j))
#define XB_XGEN(j)  (2304 + 64 * (j))
#define XB_TOP      3328
#define XB_TOPGEN   3392
#define XCD_BAR_WORDS 3456
#define XB_SPIN_CAP (1u << 18)
__device__ __forceinline__ unsigned xb_ld(unsigned* p)              { return __hip_atomic_load(p, __ATOMIC_RELAXED, __HIP_MEMORY_SCOPE_AGENT); }
__device__ __forceinline__ unsigned xb_add(unsigned* p, unsigned v) { return __hip_atomic_fetch_add(p, v, __ATOMIC_RELAXED, __HIP_MEMORY_SCOPE_AGENT); }
__device__ __forceinline__ unsigned xb_xcc_id() { return (unsigned)__builtin_amdgcn_s_getreg((3 << 11) | 20) & 0xFu; }
#define XB_SPIN(cond, bar) do { unsigned _sp = 0; while (cond) { __builtin_amdgcn_s_sleep(1); \
    if ((++_sp & 255u) == 0u) { if (xb_ld(&(bar)[XB_TMO])) break; if (_sp > XB_SPIN_CAP) { atomicAdd(&(bar)[XB_TMO], 1u); break; } } } } while (0)
struct XcdBarrier { unsigned* bar; unsigned x; volatile LAS unsigned* st; int wave0; };
__device__ __forceinline__ XcdBarrier xcd_barrier_post(unsigned* bar, volatile LAS unsigned* st, int wave0) {
    XcdBarrier b; b.bar = bar; b.x = xb_xcc_id(); b.st = st; b.wave0 = wave0;
    if (fresh_tid(wave0) == 0) (void)xb_add(&bar[XB_XCNT(b.x)], 1u);
    return b;
}
__device__ __forceinline__ void xcd_barrier_complete(unsigned* bar, unsigned x, unsigned& nloc, unsigned& nx) {
    const unsigned G = gridDim.x * gridDim.y * gridDim.z;
    unsigned sum, cnt, mine, sp = 0u;
    for (;;) {
        sum = 0u; cnt = 0u; mine = 0u;
#pragma unroll
        for (unsigned j = 0; j < 16; ++j) { const unsigned c = xb_ld(&bar[XB_XCNT(j)]); sum += c; cnt += (c > 0u) ? 1u : 0u; mine = (j == x) ? c : mine; }
        if (sum == G) break;
        __builtin_amdgcn_s_sleep(1);
        if ((++sp & 255u) == 0u) { if (xb_ld(&bar[XB_TMO])) break; if (sp > XB_SPIN_CAP) { atomicAdd(&bar[XB_TMO], 1u); break; } }
    }
    nloc = mine > 0u ? mine : 1u; nx = cnt > 0u ? cnt : 1u;
}
__device__ __forceinline__ void xcd_barrier(const XcdBarrier& b) {
    asm volatile("s_waitcnt vmcnt(0)" ::: "memory");
    __syncthreads();
    if (fresh_tid(b.wave0) == 0) {
        unsigned* bar = b.bar;
        __builtin_amdgcn_s_waitcnt(0);
        unsigned nloc = b.st[0], nx = b.st[1];
        if (nloc == 0u) { xcd_barrier_complete(bar, b.x, nloc, nx); b.st[0] = nloc; b.st[1] = nx; }
        const unsigned old = xb_add(&bar[XB_XSUB(b.x)], 1u);
        const unsigned gen = old / nloc;
        if (old + 1u == (gen + 1u) * nloc) {
            __builtin_amdgcn_fence(__ATOMIC_RELEASE, "agent");
            asm volatile("s_waitcnt vmcnt(0)" ::: "memory");
            const unsigned og = xb_add(&bar[XB_TOP], 1u);
            const unsigned tg = og / nx;
            if (og + 1u == (tg + 1u) * nx) xb_add(&bar[XB_TOPGEN], 1u);
            else XB_SPIN(xb_ld(&bar[XB_TOPGEN]) == tg, bar);
            __builtin_amdgcn_fence(__ATOMIC_ACQUIRE, "agent");
            xb_add(&bar[XB_XGEN(b.x)], 1u);
            asm volatile("s_waitcnt vmcnt(0)" ::: "memory");
        } else {
            XB_SPIN(xb_ld(&bar[XB_XGEN(b.x)]) == gen, bar);
            __builtin_amdgcn_fence(__ATOMIC_ACQUIRE, "agent");
            asm volatile("s_waitcnt vmcnt(0)" ::: "memory");
        }
    }
    __syncthreads();
}

struct Args { const float* in[30]; float* out; unsigned char* ws; int ph_lo, ph_hi; };
#define CAS __attribute__((address_space(4)))
typedef const float* cfp_t; typedef float* fp_t; typedef unsigned char* ucp_t;
struct KA {
    __device__ __forceinline__ static CAS const char* base() { CAS const char* b = (CAS const char*)__builtin_amdgcn_kernarg_segment_ptr(); asm volatile("" : "+s"(b)); return b; }
    __device__ __forceinline__ const float* in(int k) const { return *(CAS const cfp_t*)(base() + 8 * k); }
    __device__ __forceinline__ float* out() const { return *(CAS const fp_t*)(base() + 240); }
    __device__ __forceinline__ unsigned char* ws() const { return *(CAS const ucp_t*)(base() + 248); }
};
static_assert(offsetof(Args, out) == 240 && offsetof(Args, ws) == 248, "Args layout");

__device__ __forceinline__ float wave_sum(float v) {
#pragma unroll
    for (int o = 1; o < 64; o <<= 1) v += __shfl_xor(v, o);
    return v;
}
__device__ __forceinline__ void transpose_item(const float* colp, int ldw, int k0, bf16_t* WT, int K, int n0, LAS float* scr, int lane) {
    float tv[32];
#pragma unroll
    for (int i = 0; i < 32; ++i) { const int kk = 2 * i + (lane >> 5); tv[i] = colp ? colp[(size_t)(k0 + kk) * ldw] : 0.f; }
#pragma unroll
    for (int i = 0; i < 32; ++i) { const int kk = 2 * i + (lane >> 5); scr[kk * 33 + (lane & 31)] = tv[i]; }
    asm volatile("s_waitcnt lgkmcnt(0)" ::: "memory");
    const int c = lane & 7;
#pragma unroll
    for (int j = 0; j < 4; ++j) { const int n = (lane >> 3) + 8 * j; const LAS float* s = scr + (8 * c) * 33 + n;
        u32x4 o; o.x = cvtpk(s[0 * 33], s[1 * 33]); o.y = cvtpk(s[2 * 33], s[3 * 33]); o.z = cvtpk(s[4 * 33], s[5 * 33]); o.w = cvtpk(s[6 * 33], s[7 * 33]);
        *(u32x4*)(WT + (size_t)(n0 + n) * K + k0 + 8 * c) = o; }
    asm volatile("s_waitcnt lgkmcnt(0)" ::: "memory");
}
__device__ __forceinline__ int mix_src_col(int n) {
    const int pn = n >> 8, lc = n & 255;
    if (pn < 4) return (lc < 128) ? (pn * 128 + lc) : (1024 + pn * 128 + (lc - 128));
    if (pn < 6) return 512 + (pn - 4) * 256 + lc;
    if (pn < 8) return 1536 + (pn - 6) * 256 + lc;
    if (pn == 8) return (lc < 128) ? (2048 + lc) : (2176 + (lc - 128));
    if (pn < 11) return 2304 + (pn - 9) * 256 + lc;
    return (lc < 72) ? (2816 + lc) : -1;
}
__device__ __forceinline__ void cvt_copy(const float* src, bf16_t* dst, size_t n8, int gthread, int nthreads) {
    size_t i = gthread;
    for (; i + 3 * (size_t)nthreads < n8; i += 4 * (size_t)nthreads) {
        f32x4 a[4], b[4];
#pragma unroll
        for (int j = 0; j < 4; ++j) { const size_t q = i + (size_t)j * nthreads; a[j] = *(const f32x4*)(src + q * 8); b[j] = *(const f32x4*)(src + q * 8 + 4); }
#pragma unroll
        for (int j = 0; j < 4; ++j) { const size_t q = i + (size_t)j * nthreads; u32x4 o; o.x = cvtpk(a[j][0], a[j][1]); o.y = cvtpk(a[j][2], a[j][3]); o.z = cvtpk(b[j][0], b[j][1]); o.w = cvtpk(b[j][2], b[j][3]); *(u32x4*)(dst + q * 8) = o; }
    }
    for (; i < n8; i += nthreads) { const f32x4 a = *(const f32x4*)(src + i * 8), b = *(const f32x4*)(src + i * 8 + 4);
        u32x4 o; o.x = cvtpk(a[0], a[1]); o.y = cvtpk(a[2], a[3]); o.z = cvtpk(b[0], b[1]); o.w = cvtpk(b[2], b[3]); *(u32x4*)(dst + i * 8) = o; }
}
__device__ __forceinline__ void phase_prologue(const KA& A, LAS unsigned char* lds, int vcu, int G, int wave0) {
    const int tid = fresh_tid(wave0), lane = tid & 63, wave = __builtin_amdgcn_readfirstlane(tid >> 6);
    LAS float* scr = (LAS float*)(lds + wave * 16384);
    const int gw = vcu * NWAVES + wave, NGW = G * NWAVES;
    unsigned char* ws = A.ws();
    constexpr int I_GU = (D / 64) * (NGU / 32), I_DN = (FF / 64) * (D / 32), I_MIX = (D / 64) * (NMIX / 32), I_SQ = (D / 64) * (D / 32), I_MV = (256 / 64) * (D / 32);
    constexpr int NITEMS = 2 * I_GU + 2 * I_DN + I_MIX + 5 * I_SQ + 8 * I_MV;
    for (int it = gw; it < NITEMS; it += NGW) {
        int r = it;
        if (r < 2 * I_GU) { const int l = r / I_GU; r -= l * I_GU; const int nblk = NGU / 32, kb = r / nblk, nb = r % nblk, n = nb * 32 + (lane & 31);
            const int j = n >> 8, lc = n & 255; const float* W = A.in((l ? 25 : 9) + (lc >> 7)); const int col = j * 128 + (lc & 127);
            transpose_item(W + col, FF, kb * 64, (bf16_t*)(ws + (l ? WS_WGU2 : WS_WGU1)), D, nb * 32, scr, lane); continue; } r -= 2 * I_GU;
        if (r < 2 * I_DN) { const int l = r / I_DN; r -= l * I_DN; const int nblk = D / 32, kb = r / nblk, nb = r % nblk;
            transpose_item(A.in(l ? 27 : 11) + nb * 32 + (lane & 31), D, kb * 64, (bf16_t*)(ws + (l ? WS_WD2 : WS_WD1)), FF, nb * 32, scr, lane); continue; } r -= 2 * I_DN;
        if (r < I_MIX) { const int nblk = NMIX / 32, kb = r / nblk, nb = r % nblk; const int sc = mix_src_col(nb * 32 + (lane & 31));
            transpose_item(sc >= 0 ? A.in(14) + sc : nullptr, NMIX_SRC, kb * 64, (bf16_t*)(ws + WS_WMIX), D, nb * 32, scr, lane); continue; } r -= I_MIX;
        if (r < 5 * I_SQ) { const int w = r / I_SQ; r -= w * I_SQ; const int nblk = D / 32, kb = r / nblk, nb = r % nblk;
            const int src = (w == 0) ? 16 : 18 + w;
            const size_t dst = (w == 0) ? WS_WMO : (w == 1) ? WS_WQ : (w == 2) ? WS_WK : (w == 3) ? WS_WV : WS_WO;
            transpose_item(A.in(src) + nb * 32 + (lane & 31), D, kb * 64, (bf16_t*)(ws + dst), D, nb * 32, scr, lane); continue; } r -= 5 * I_SQ;
        { const int b = r / I_MV; r -= b * I_MV; const int nblk = D / 32, kb = r / nblk, nb = r % nblk;
            transpose_item(A.in(7) + (size_t)b * 256 * D + nb * 32 + (lane & 31), D, kb * 64, (bf16_t*)(ws + WS_MVT) + (size_t)(2 + b) * 256 * D + (nb >> 3) * 256, D, (nb & 7) * 32, scr, lane); }
    }
    const int gt = gw * 64 + lane, NT = NGW * 64;
    cvt_copy(A.in(0), (bf16_t*)(ws + WS_XB), (size_t)MP * D / 8, gt, NT);
    cvt_copy(A.in(1), (bf16_t*)(ws + WS_XB) + (size_t)MP * D, (size_t)MS * D / 8, gt, NT);
    cvt_copy(A.in(8), (bf16_t*)(ws + WS_MEMPB), (size_t)512 * D / 8, gt, NT);
    for (int b = 0; b < DEC_B; ++b) {
        cvt_copy(A.in(3) + (size_t)b * PAST * 128, (bf16_t*)(ws + WS_KS) + (size_t)b * SKS * 128, (size_t)PAST * 128 / 8, gt, NT);
        cvt_copy(A.in(4) + (size_t)b * PAST * 128, (bf16_t*)(ws + WS_VS) + (size_t)b * SKS * 128, (size_t)PAST * 128 / 8, gt, NT);
        cvt_copy(A.in(5) + (size_t)b * PAST * 64, (bf16_t*)(ws + WS_KIS) + (size_t)b * SKS * 64, (size_t)PAST * 64 / 8, gt, NT);
    }
    cvt_copy(A.in(6), (bf16_t*)(ws + WS_MK) + (size_t)2 * 256 * D, (size_t)DEC_B * 256 * D / 8, gt, NT);
}
__device__ __forceinline__ void phase_memconv(const KA& A, LAS unsigned char* lds, int vcu, int G, int wave0) {
    const int tid = fresh_tid(wave0), lane = tid & 63, wave = __builtin_amdgcn_readfirstlane(tid >> 6);
    LAS float* scr = (LAS float*)(lds + wave * 16384);
    const int gw = vcu * NWAVES + wave, NGW = G * NWAVES;
    unsigned char* ws = A.ws();
    constexpr int I_MV = (256 / 64) * (D / 32);
    for (int it = gw; it < 2 * I_MV; it += NGW) { const int b = it / I_MV, r = it - b * I_MV; const int nblk = D / 32, kb = r / nblk, nb = r % nblk;
        transpose_item(A.out() + O_MVP + (size_t)b * 256 * D + nb * 32 + (lane & 31), D, kb * 64, (bf16_t*)(ws + WS_MVT) + (size_t)b * 256 * D + (nb >> 3) * 256, D, (nb & 7) * 32, scr, lane); }
    const int gt = gw * 64 + lane, NT = NGW * 64;
    cvt_copy(A.out() + O_MKP, (bf16_t*)(ws + WS_MK), (size_t)2 * 256 * D / 8, gt, NT);
}
__device__ __forceinline__ void phase_ln(float* X, bf16_t* XB, const float* g, const float* bta, int vcu, int G, int wave0, const unsigned* err = nullptr) {
    const int tid = fresh_tid(wave0), lane = tid & 63, wave = __builtin_amdgcn_readfirstlane(tid >> 6);
    const int gw = vcu * NWAVES + wave, NGW = G * NWAVES;
    f32x4 gv[4], bv[4];
#pragma unroll
    for (int j = 0; j < 4; ++j) { gv[j] = *(const f32x4*)(g + 256 * j + 4 * lane); bv[j] = *(const f32x4*)(bta + 256 * j + 4 * lane); }
    if (err && __hip_atomic_load(err, __ATOMIC_RELAXED, __HIP_MEMORY_SCOPE_AGENT) != 0u) { const float q = __builtin_nanf("");
#pragma unroll
        for (int j = 0; j < 4; ++j) bv[j] = (f32x4){q, q, q, q}; }
    for (int mrow = gw; mrow < M; mrow += NGW) {
        f32x4* xr = (f32x4*)(X + (size_t)mrow * D) + lane;
        f32x4 v[4]; float s = 0.f;
#pragma unroll
        for (int j = 0; j < 4; ++j) { v[j] = xr[64 * j]; s += (v[j][0] + v[j][1]) + (v[j][2] + v[j][3]); }
        const float mean = wave_sum(s) * (1.f / D); float s2 = 0.f;
#pragma unroll
        for (int j = 0; j < 4; ++j) { v[j] = v[j] - mean; s2 += (v[j][0] * v[j][0] + v[j][1] * v[j][1]) + (v[j][2] * v[j][2] + v[j][3] * v[j][3]); }
        const float rstd = 1.f / sqrtf(wave_sum(s2) * (1.f / D) + LN_EPS);
        u32x2* o8 = (u32x2*)(XB + (size_t)mrow * D) + lane;
#pragma unroll
        for (int j = 0; j < 4; ++j) { const f32x4 y = v[j] * rstd * gv[j] + bv[j]; xr[64 * j] = y; u32x2 w; w.x = cvtpk(y[0], y[1]); w.y = cvtpk(y[2], y[3]); o8[64 * j] = w; }
    }
}

constexpr int CAP = 1024;
constexpr int IDX_BUF = 0, IDX_STAGE = 32 * CAP * 4, IDX_HIST = IDX_STAGE + 2 * 8192, IDX_FLAG = IDX_HIST + 8 * 1024, IDX_END = IDX_FLAG + 128;
static_assert(IDX_END <= LDS_BYTES, "indexer LDS");
#define DPP_ROR(v, n) ((unsigned)__builtin_amdgcn_update_dpp(0, (int)(v), 0x120 + (n), 0xf, 0xf, false))
#define DPP_SHL0(v, n) ((unsigned)__builtin_amdgcn_update_dpp(0, (int)(v), 0x100 + (n), 0xf, 0xf, true))
__device__ __forceinline__ unsigned wave_maxu(unsigned v) {
    unsigned t;
    t = DPP_ROR(v, 8); v = v > t ? v : t; t = DPP_ROR(v, 4); v = v > t ? v : t; t = DPP_ROR(v, 2); v = v > t ? v : t; t = DPP_ROR(v, 1); v = v > t ? v : t;
    const unsigned a = __builtin_amdgcn_readlane(v, 0), b = __builtin_amdgcn_readlane(v, 16), c = __builtin_amdgcn_readlane(v, 32), d = __builtin_amdgcn_readlane(v, 48);
    const unsigned ab = a > b ? a : b, cd = c > d ? c : d; return ab > cd ? ab : cd;
}
__device__ __forceinline__ unsigned wave_minu(unsigned v) {
    unsigned t;
    t = DPP_ROR(v, 8); v = v < t ? v : t; t = DPP_ROR(v, 4); v = v < t ? v : t; t = DPP_ROR(v, 2); v = v < t ? v : t; t = DPP_ROR(v, 1); v = v < t ? v : t;
    const unsigned a = __builtin_amdgcn_readlane(v, 0), b = __builtin_amdgcn_readlane(v, 16), c = __builtin_amdgcn_readlane(v, 32), d = __builtin_amdgcn_readlane(v, 48);
    const unsigned ab = a < b ? a : b, cd = c < d ? c : d; return ab < cd ? ab : cd;
}
__device__ __forceinline__ unsigned wave_select256(LAS unsigned* buf, int n, LAS unsigned* hist, int lane, unsigned* err) {
    unsigned e[16];
    unsigned lo = 0xFFFFFFFFu, hi = 0u;
#pragma unroll
    for (int i = 0; i < 16; ++i) { const int idx = i * 64 + lane; e[i] = (idx < n) ? buf[idx] : 0u; hi = e[i] > hi ? e[i] : hi; const unsigned x = (idx < n) ? e[i] : 0xFFFFFFFFu; lo = x < lo ? x : lo; }
    hi = wave_maxu(hi); lo = wave_minu(lo);
    const int row = lane >> 4;
    int need = TOPK; unsigned T = lo;
    for (int pass = 0; pass < 5; ++pass) {
        const unsigned range = hi - lo;
        const int bits = range ? 32 - __builtin_clz(range) : 0;
        const int shift = bits > 8 ? bits - 8 : 0;
        *(LAS u32x4*)(hist + lane * 4) = (u32x4){0u, 0u, 0u, 0u};
        const unsigned span = hi - lo;
#pragma unroll
        for (int i = 0; i < 16; ++i) { const unsigned d = e[i] - lo; if (d <= span) __hip_atomic_fetch_add(hist + (d >> shift), 1u, __ATOMIC_RELAXED, __HIP_MEMORY_SCOPE_WORKGROUP); }
        asm volatile("s_waitcnt lgkmcnt(0)" ::: "memory");
        const u32x4 hv = *(LAS u32x4*)(hist + lane * 4);
        const unsigned s4 = hv.x + hv.y + hv.z + hv.w;
        unsigned inc = s4;
        inc += DPP_SHL0(inc, 1); inc += DPP_SHL0(inc, 2); inc += DPP_SHL0(inc, 4); inc += DPP_SHL0(inc, 8);
        const unsigned r1 = __builtin_amdgcn_readlane(inc, 16), r2 = __builtin_amdgcn_readlane(inc, 32), r3 = __builtin_amdgcn_readlane(inc, 48);
        const unsigned o2 = r3, o1 = r3 + r2, o0 = r3 + r2 + r1;
        inc += (row == 0) ? o0 : (row == 1) ? o1 : (row == 2) ? o2 : 0u;
        const int exc = (int)(inc - s4);
        const unsigned long long mb = __builtin_amdgcn_ballot_w64(exc < need && (int)inc >= need);
        const int L = mb ? __builtin_ctzll(mb) : 0;
        const int b3 = __builtin_amdgcn_readlane((int)hv.w, L), b2 = __builtin_amdgcn_readlane((int)hv.z, L), b1 = __builtin_amdgcn_readlane((int)hv.y, L), b0 = __builtin_amdgcn_readlane((int)hv.x, L);
        int above = __builtin_amdgcn_readlane(exc, L); int binT, cb;
        if (above + b3 >= need) { binT = 3; cb = b3; }
        else { above += b3; if (above + b2 >= need) { binT = 2; cb = b2; }
            else { above += b2; if (above + b1 >= need) { binT = 1; cb = b1; } else { above += b1; binT = 0; cb = b0; } } }
        binT += 4 * L;
        const unsigned lo2 = lo + ((unsigned)binT << shift);
        need -= above; T = lo2;
        if (shift == 0 || need == cb) break;
        unsigned hi2 = lo2 + ((1u << shift) - 1u); if (hi2 < lo2) hi2 = 0xFFFFFFFFu;
        hi = hi < hi2 ? hi : hi2; lo = lo2;
    }
    int pos = 0;
#pragma unroll
    for (int i = 0; i < 16; ++i) { const bool k = e[i] >= T && e[i] != 0u; const unsigned long long mk = __builtin_amdgcn_ballot_w64(k);
        const int pre = __builtin_amdgcn_mbcnt_hi((unsigned)(mk >> 32), __builtin_amdgcn_mbcnt_lo((unsigned)mk, 0u));
        if (k) buf[pos + pre] = e[i]; pos += __builtin_popcountll(mk); }
    asm volatile("s_waitcnt lgkmcnt(0)" ::: "memory");
    if (pos != TOPK && lane == 0) __hip_atomic_fetch_or(err, 1u, __ATOMIC_RELAXED, __HIP_MEMORY_SCOPE_AGENT);
    return T;
}
__device__ __forceinline__ float relu_f(float x) { return __builtin_amdgcn_fmed3f(x, 0.f, __builtin_inff()); }
__device__ __forceinline__ void indexer_unit(LAS unsigned char* lds, const bf16_t* QI, const float* WI, int row0, const bf16_t* KI, int S, unsigned short* SEL, int wave0, unsigned* err) {
    const int tid = fresh_tid(wave0), lane = tid & 63, wave = __builtin_amdgcn_readfirstlane(tid >> 6), h = lane >> 5, rho = lane & 31;
    LAS unsigned* bufw = (LAS unsigned*)(lds + IDX_BUF) + (size_t)(wave * 4) * CAP;
    LAS unsigned* hist = (LAS unsigned*)(lds + IDX_HIST) + wave * 256;
    const int ql = 2 * (rho >> 4) + ((rho >> 2) & 1), head = (rho & 3) + 4 * ((rho >> 3) & 1);
    bf16x8 a[4];
#pragma unroll
    for (int s = 0; s < 4; ++s) a[s] = *(const bf16x8*)(QI + (size_t)(row0 + wave * 4 + ql) * 512 + head * 64 + 16 * s + 8 * h);
    float wa[8], wb[8];
#pragma unroll
    for (int j = 0; j < 8; ++j) { wa[j] = WI[(size_t)(row0 + wave * 4 + h) * 8 + j]; wb[j] = WI[(size_t)(row0 + wave * 4 + 2 + h) * 8 + j]; }
    const unsigned bufA = (unsigned)(IDX_BUF + (wave * 4 + h) * CAP * 4), bufB = bufA + 2 * CAP * 4;
    unsigned boff[4];
#pragma unroll
    for (int s = 0; s < 4; ++s) boff[s] = (unsigned)(IDX_STAGE + rho * 128 + (((2 * s + h) ^ ((rho >> 1) & 7)) << 4));
    unsigned tauA = 0u, tauB = 0u;
    int cnt0 = 0, cnt1 = 0, cnt2 = 0, cnt3 = 0;
    const int ntile = (S + 63) >> 6;
    const int skey = tid >> 3, schunk = tid & 7;
    const unsigned sdst = (unsigned)(IDX_STAGE + skey * 128 + ((schunk ^ ((skey >> 1) & 7)) << 4));
    const bf16_t* kip = KI + (size_t)skey * 64 + schunk * 8;
    u32x4 p0, p1, p2, p3;
#define IDX_LD(T) (((T) < ntile && (T) * 64 + skey < S) ? *(const u32x4*)(kip + (size_t)(T) * 64 * 64) : (u32x4){0u, 0u, 0u, 0u})
    p0 = IDX_LD(0); p1 = IDX_LD(1); p2 = IDX_LD(2); p3 = IDX_LD(3);
    unsigned kbits = 8191u - (unsigned)rho;
    for (int t = 0; t < ntile; ++t) {
        const unsigned so = (unsigned)(t & 1) * 8192u;
        *(LAS u32x4*)(lds + so + sdst) = p0;
        { const int mc = max(max(cnt0, cnt1), max(cnt2, cnt3)); if (lane == 0) *(LAS unsigned*)(lds + IDX_FLAG + (t & 1) * 64 + wave * 4) = (mc > CAP - 128) ? 1u : 0u; }
        __syncthreads();
        p0 = p1; p1 = p2; p2 = p3; p3 = IDX_LD(t + 4);
        { const unsigned fl = *(const LAS unsigned*)(lds + IDX_FLAG + (t & 1) * 64 + (lane & 7) * 4);
          if (__builtin_amdgcn_ballot_w64(fl != 0u) != 0ull) {
            if (cnt0 > CAP / 2) { const unsigned T = wave_select256(bufw, cnt0, hist, lane, err); cnt0 = TOPK; if (h == 0) tauA = T; }
            if (cnt1 > CAP / 2) { const unsigned T = wave_select256(bufw + CAP, cnt1, hist, lane, err); cnt1 = TOPK; if (h == 1) tauA = T; }
            if (cnt2 > CAP / 2) { const unsigned T = wave_select256(bufw + 2 * CAP, cnt2, hist, lane, err); cnt2 = TOPK; if (h == 0) tauB = T; }
            if (cnt3 > CAP / 2) { const unsigned T = wave_select256(bufw + 3 * CAP, cnt3, hist, lane, err); cnt3 = TOPK; if (h == 1) tauB = T; } } }
#pragma unroll
        for (int sub = 0; sub < 2; ++sub) {
            if (t * 64 + sub * 32 >= S) break;
            f32x16 acc = {0.f, 0.f, 0.f, 0.f, 0.f, 0.f, 0.f, 0.f, 0.f, 0.f, 0.f, 0.f, 0.f, 0.f, 0.f, 0.f};
#pragma unroll
            for (int s = 0; s < 4; ++s) { const bf16x8 b = *(const LAS bf16x8*)(lds + so + sub * 4096 + boff[s]);
                acc = __builtin_amdgcn_mfma_f32_32x32x16_bf16(a[s], b, acc, 0, 0, 0); }
            float sa = wa[0] * relu_f(acc[0]), sb = wb[0] * relu_f(acc[8]);
#pragma unroll
            for (int j = 1; j < 8; ++j) { sa = __builtin_fmaf(wa[j], relu_f(acc[j]), sa); sb = __builtin_fmaf(wb[j], relu_f(acc[8 + j]), sb); }
            sa += 0.f; sb += 0.f;
            const unsigned kb = kbits - (unsigned)(sub * 32);
            const unsigned ua = __float_as_uint(sa), ub = __float_as_uint(sb);
            const unsigned pa = ((ua ^ ((unsigned)((int)ua >> 31) | 0x80000000u)) & 0xFFFFE000u) | kb;
            const unsigned pb = ((ub ^ ((unsigned)((int)ub >> 31) | 0x80000000u)) & 0xFFFFE000u) | kb;
            const bool okA = pa > tauA, okB = pb > tauB;
            const unsigned long long mA = __builtin_amdgcn_ballot_w64(okA), mB = __builtin_amdgcn_ballot_w64(okB);
            const unsigned mAl = (unsigned)mA, mAh = (unsigned)(mA >> 32), mBl = (unsigned)mB, mBh = (unsigned)(mB >> 32);
            const int pAl = __builtin_popcount(mAl), pBl = __builtin_popcount(mBl);
            const int preA = (int)__builtin_amdgcn_mbcnt_hi(mAh, __builtin_amdgcn_mbcnt_lo(mAl, 0u)) + (h ? cnt1 - pAl : cnt0);
            const int preB = (int)__builtin_amdgcn_mbcnt_hi(mBh, __builtin_amdgcn_mbcnt_lo(mBl, 0u)) + (h ? cnt3 - pBl : cnt2);
            if (okA) *(LAS unsigned*)(lds + bufA + preA * 4) = pa;
            if (okB) *(LAS unsigned*)(lds + bufB + preB * 4) = pb;
            cnt0 += pAl; cnt1 += __builtin_popcount(mAh); cnt2 += pBl; cnt3 += __builtin_popcount(mBh);
        }
        kbits -= 64u;
    }
#undef IDX_LD
    asm volatile("s_waitcnt lgkmcnt(0)" ::: "memory");
#pragma unroll
    for (int q = 0; q < 4; ++q) {
        const int c = (q == 0) ? cnt0 : (q == 1) ? cnt1 : (q == 2) ? cnt2 : cnt3;
        LAS unsigned* bq = bufw + q * CAP;
        if (c > TOPK) (void)wave_select256(bq, c, hist, lane, err);
        unsigned short* o = SEL + (size_t)(row0 + wave * 4 + q) * 256;
#pragma unroll
        for (int i = 0; i < 4; ++i) o[i * 64 + lane] = (unsigned short)(8191u - (bq[i * 64 + lane] & 8191u));
    }
    __syncthreads();
}
__device__ __forceinline__ void phase_indexer(const KA& A, LAS unsigned char* lds, int blk, int G, int wave0) {
    unsigned char* ws = A.ws();
    const bf16_t* QI = (const bf16_t*)(ws + WS_QIB); const float* WI = (const float*)(ws + WS_WIF); unsigned short* SEL = (unsigned short*)(ws + WS_SEL); unsigned* err = (unsigned*)(ws + WS_CTL) + 16;
    for (int round = 0;; ++round) {
        const int pos = round * G + ((round & 1) ? (G - 1 - blk) : blk);
        if (round * G >= 504) break;
        if (pos >= 504) continue;
        if (pos >= 256 && pos < 264) { const int b = pos - 256;
            indexer_unit(lds, QI, WI, MP + b * 32, (const bf16_t*)(ws + WS_KIS) + (size_t)b * SKS * 64, SKS, SEL, wave0, err);
        } else { const int v = (pos < 256) ? pos : pos - 264; const int c = (pos < 256) ? 127 - (v >> 2) : 63 - (v >> 2); const int b = (v >> 1) & 1, half = v & 1;
            indexer_unit(lds, QI, WI, b * SEQ + c * 64 + half * 32, (const bf16_t*)(ws + WS_KIP) + (size_t)b * SEQ * 64, 64 * (c + 1), SEL, wave0, err);
        }
    }
}
__device__ __forceinline__ void phase_conv(const KA& A, int blk, int G, int wave0) {
    unsigned char* ws = A.ws();
    const bf16_t* U = (const bf16_t*)(ws + WS_U); const bf16_t* BG = (const bf16_t*)(ws + WS_BG); bf16_t* Y = (bf16_t*)(ws + WS_YCAT);
    const float* cw = A.in(15); const float* cc = A.in(2);
    const int tid = fresh_tid(wave0), ch = (tid & 63) * 8, rsub = tid >> 6;
    float w0[8], w1[8], w2[8];
#pragma unroll
    for (int e = 0; e < 8; ++e) { w0[e] = cw[ch + e]; w1[e] = cw[512 + ch + e]; w2[e] = cw[1024 + ch + e]; }
    for (int row = blk * 8 + rsub; row < M; row += G * 8) {
        int t, b; const bool samp = row >= MP; if (samp) { t = (row - MP) & 31; b = (row - MP) >> 5; } else { t = row & (SEQ - 1); b = row >> 13; }
        float u0[8], u1[8], u2[8], bg[8];
        { const u32x4 x = *(const u32x4*)(U + (size_t)row * 512 + ch); const u32x4 g = *(const u32x4*)(BG + (size_t)row * 512 + ch);
#pragma unroll
          for (int e = 0; e < 4; ++e) { u2[2 * e] = __uint_as_float(x[e] << 16); u2[2 * e + 1] = __uint_as_float(x[e] & 0xFFFF0000u); bg[2 * e] = __uint_as_float(g[e] << 16); bg[2 * e + 1] = __uint_as_float(g[e] & 0xFFFF0000u); } }
        if (t >= 1) { const u32x4 x = *(const u32x4*)(U + (size_t)(row - 1) * 512 + ch);
#pragma unroll
            for (int e = 0; e < 4; ++e) { u1[2 * e] = __uint_as_float(x[e] << 16); u1[2 * e + 1] = __uint_as_float(x[e] & 0xFFFF0000u); } }
        else {
#pragma unroll
            for (int e = 0; e < 8; ++e) u1[e] = samp ? cc[(size_t)(b * 2 + 1) * 512 + ch + e] : 0.f; }
        if (t >= 2) { const u32x4 x = *(const u32x4*)(U + (size_t)(row - 2) * 512 + ch);
#pragma unroll
            for (int e = 0; e < 4; ++e) { u0[2 * e] = __uint_as_float(x[e] << 16); u0[2 * e + 1] = __uint_as_float(x[e] & 0xFFFF0000u); } }
        else {
#pragma unroll
            for (int e = 0; e < 8; ++e) u0[e] = samp ? cc[(size_t)(b * 2 + t) * 512 + ch + e] : 0.f; }
        float y[8];
#pragma unroll
        for (int e = 0; e < 8; ++e) y[e] = bg[e] * (w0[e] * u0[e] + w1[e] * u1[e] + w2[e] * u2[e]);
        u32x4 o; o.x = cvtpk(y[0], y[1]); o.y = cvtpk(y[2], y[3]); o.z = cvtpk(y[4], y[5]); o.w = cvtpk(y[6], y[7]);
        *(u32x4*)(Y + (size_t)row * D + ch) = o;
    }
}

constexpr int AT_VPITCH = 288, AT_WAVE_BYTES = 32 * AT_VPITCH + 512;
static_assert(8 * AT_WAVE_BYTES <= LDS_BYTES, "attention LDS");
__device__ __forceinline__ void phase_attn(const KA& A, LAS unsigned char* lds, int vcu, int G, int wave0) {
    unsigned char* ws = A.ws();
    const int tid = fresh_tid(wave0), lane = tid & 63, wave = __builtin_amdgcn_readfirstlane(tid >> 6), n = lane & 15, g = lane >> 4;
    LAS unsigned char* vl = lds + wave * AT_WAVE_BYTES;
    LAS unsigned short* il = (LAS unsigned short*)(vl + 32 * AT_VPITCH);
    const bf16_t* QB = (const bf16_t*)(ws + WS_QB); const unsigned short* SEL = (const unsigned short*)(ws + WS_SEL); bf16_t* Y = (bf16_t*)(ws + WS_YCAT);
    const int gw = vcu * NWAVES + wave, NGW = G * NWAVES;
    for (int row = gw; row < M; row += NGW) {
        const bf16_t* Kb; const bf16_t* Vb; int nkeys; bool use_sel;
        if (row < MP) { const int b = row >> 13, c = (row & (SEQ - 1)) >> 6; Kb = (const bf16_t*)(ws + WS_KP) + (size_t)b * SEQ * 128; Vb = (const bf16_t*)(ws + WS_VP) + (size_t)b * SEQ * 128;
            use_sel = c >= 4; nkeys = use_sel ? 256 : 64 * (c + 1); }
        else { const int b = (row - MP) >> 5; Kb = (const bf16_t*)(ws + WS_KS) + (size_t)b * SKS * 128; Vb = (const bf16_t*)(ws + WS_VS) + (size_t)b * SKS * 128; use_sel = true; nkeys = 256; }
        { u32x2 w;
          if (use_sel) w = *(const u32x2*)(SEL + (size_t)row * 256 + lane * 4);
          else { const int j0 = lane * 4; const int i0 = j0 < nkeys ? j0 : 0, i1 = j0 + 1 < nkeys ? j0 + 1 : 0, i2 = j0 + 2 < nkeys ? j0 + 2 : 0, i3 = j0 + 3 < nkeys ? j0 + 3 : 0; w.x = (unsigned)i0 | ((unsigned)i1 << 16); w.y = (unsigned)i2 | ((unsigned)i3 << 16); }
          *(LAS u32x2*)(il + lane * 4) = w; }
        bf16x8 bq[4];
#pragma unroll
        for (int s = 0; s < 4; ++s) { bq[s] = (bf16x8){0, 0, 0, 0, 0, 0, 0, 0}; if (n < 8 && (n >> 2) == (s >> 1)) bq[s] = *(const bf16x8*)(QB + (size_t)row * 512 + n * 64 + 32 * (s & 1) + 8 * g); }
        asm volatile("s_waitcnt lgkmcnt(0)" ::: "memory");
        f32x4 sc[16];
#pragma unroll
        for (int i = 0; i < 16; ++i) {
            const int kidx = il[16 * i + n];
            const bf16_t* kr = Kb + (size_t)kidx * 128 + 8 * g;
            f32x4 acc = {0.f, 0.f, 0.f, 0.f};
#pragma unroll
            for (int s = 0; s < 4; ++s) { const bf16x8 ka = *(const bf16x8*)(kr + 32 * s); acc = __builtin_amdgcn_mfma_f32_16x16x32_bf16(ka, bq[s], acc, 0, 0, 0); }
            sc[i] = acc;
            if (i & 1) __builtin_amdgcn_sched_barrier(0);
        }
        const float cs = 0.125f * 1.4426950408889634f;
        float mx = -INFINITY;
#pragma unroll
        for (int i = 0; i < 16; ++i)
#pragma unroll
            for (int r = 0; r < 4; ++r) { const bool valid = (16 * i + 4 * g + r) < nkeys; sc[i][r] = valid ? sc[i][r] : -INFINITY; mx = fmaxf(mx, sc[i][r]); }
        mx = fmaxf(mx, __shfl_xor(mx, 16)); mx = fmaxf(mx, __shfl_xor(mx, 32));
        float ls = 0.f;
#pragma unroll
        for (int i = 0; i < 16; ++i)
#pragma unroll
            for (int r = 0; r < 4; ++r) { const float p = __builtin_amdgcn_exp2f((sc[i][r] - mx) * cs); sc[i][r] = p; ls += p; }
        ls += __shfl_xor(ls, 16); ls += __shfl_xor(ls, 32);
        f32x4 o[8];
#pragma unroll
        for (int nt = 0; nt < 8; ++nt) o[nt] = (f32x4){0.f, 0.f, 0.f, 0.f};
#pragma unroll
        for (int c8 = 0; c8 < 8; ++c8) {
            u32x4 vr[8];
#pragma unroll
            for (int i = 0; i < 8; ++i) { const int lr = 4 * i + g; const int kidx = il[32 * c8 + lr]; vr[i] = *(const u32x4*)(Vb + (size_t)kidx * 128 + n * 8); }
#pragma unroll
            for (int i = 0; i < 8; ++i) *(LAS u32x4*)(vl + (4 * i + g) * AT_VPITCH + n * 16) = vr[i];
            bf16x8 pa; { u32x4 w; w.x = cvtpk(sc[2 * c8][0], sc[2 * c8][1]); w.y = cvtpk(sc[2 * c8][2], sc[2 * c8][3]); w.z = cvtpk(sc[2 * c8 + 1][0], sc[2 * c8 + 1][1]); w.w = cvtpk(sc[2 * c8 + 1][2], sc[2 * c8 + 1][3]); pa = __builtin_bit_cast(bf16x8, w); }
            LAS unsigned char* tb = vl + (4 * g + (n >> 2)) * AT_VPITCH + (n & 3) * 8;
#pragma unroll
            for (int nt = 0; nt < 8; ++nt) {
                const s16x4 lo = __builtin_bit_cast(s16x4, __builtin_amdgcn_ds_read_tr16_b64_v4i16((LAS s16x4*)(tb + nt * 32)));
                const s16x4 hi = __builtin_bit_cast(s16x4, __builtin_amdgcn_ds_read_tr16_b64_v4i16((LAS s16x4*)(tb + 16 * AT_VPITCH + nt * 32)));
                const bf16x8 vb = (bf16x8){lo[0], lo[1], lo[2], lo[3], hi[0], hi[1], hi[2], hi[3]};
                o[nt] = __builtin_amdgcn_mfma_f32_16x16x32_bf16(pa, vb, o[nt], 0, 0, 0);
            }
            asm volatile("s_waitcnt lgkmcnt(0)" ::: "memory");
            __builtin_amdgcn_sched_barrier(0);
        }
#pragma unroll
        for (int r = 0; r < 4; ++r) { const float inv = 1.f / __shfl(ls, 4 * (g & 1) + r);
            if (g < 2) {
#pragma unroll
                for (int j = 0; j < 4; ++j) { const float val = (g == 0 ? o[j][r] : o[4 + j][r]) * inv; const unsigned w = cvtpk(val, val);
                    Y[(size_t)row * D + 512 + (4 * g + r) * 64 + 16 * j + n] = (bf16_t)(w & 0xFFFFu); } } }
    }
}

constexpr int N_PHASES = 18;
template <int PH_LO, int PH_HI>
__global__ void __launch_bounds__(NWAVES * 64, 2) fwd_kernel(Args args) {
    extern __shared__ __attribute__((aligned(16))) unsigned char lds_raw[];
    LAS unsigned char* lds = (LAS unsigned char*)lds_raw;
    const int tid = threadIdx.x; const int wave0 = __builtin_amdgcn_readfirstlane(tid >> 6);
    const int G = gridDim.x, bx = blockIdx.x;
    const int vcu = (G % 8 == 0) ? (bx % 8) * (G / 8) + bx / 8 : bx;
    const KA ka{}; unsigned char* ws = ka.ws(); float* out = ka.out();
    volatile LAS unsigned* MISC = (volatile LAS unsigned*)(lds + LDS_BYTES - 64);
    if (fresh_tid(wave0) < 16) MISC[fresh_tid(wave0)] = 0u;
    __syncthreads();
    unsigned* ctl = (unsigned*)(ws + WS_CTL);
    XcdBarrier bar; bar.bar = ctl + 4096; bar.x = 0; bar.st = nullptr; bar.wave0 = wave0;
    constexpr bool one_launch = (PH_HI - PH_LO) > 1;
    if constexpr (one_launch) bar = xcd_barrier_post(ctl + 4096, MISC + 8, wave0);
#define IN(k) (PH_LO <= (k) && (k) < PH_HI)
#define SEAM(k) do { if constexpr (IN(k) && IN((k) + 1)) xcd_barrier(bar); } while (0)
    bf16_t* XB = (bf16_t*)(ws + WS_XB); float* X32 = out + O_Y;

    if constexpr (IN(0)) { phase_prologue(ka, lds, vcu, G, wave0); if constexpr ((REPEAT_MASK >> 0) & 1) { xcd_barrier(bar); phase_prologue(ka, lds, vcu, G, wave0); } } SEAM(0);
    if constexpr (IN(1)) {
        { pg8::Gemm g{D, D, D}; pg8::StaticOrder S; sgemm(lds, XB + (size_t)MP * D, D, (const bf16_t*)(ws + WS_WGU1), D, D, 4 * (FF / 32), BMapPair{}, SEpiGateUp{(bf16_t*)(ws + WS_HB)}, bx, G, wave0);
          S.init(XB, ws + WS_WGU1, D, D, MP, NGU, G, bx); EpiGateUp E{(bf16_t*)(ws + WS_HB)};
          pg8::gemm_phase<EpiGateUp, pg8::StaticOrder, true, true>(lds, g, S, E, wave0); }
        if constexpr ((REPEAT_MASK >> 1) & 1) { xcd_barrier(bar); pg8::Gemm g{D, D, D}; pg8::StaticOrder S; S.init(XB, ws + WS_WGU1, D, D, MP, NGU, G, bx); EpiGateUp E{(bf16_t*)(ws + WS_HB)};
          pg8::gemm_phase<EpiGateUp, pg8::StaticOrder, true, true>(lds, g, S, E, wave0); }
        if (bx >= G - 16) { const int j = bx - (G - 16); pg8::OneUnit S; S.u0.pm = j >> 3; S.u0.pn = j & 3; S.u0.aux = (j >> 2) & 1;
            S.u0.a = (const char*)(ws + WS_MEMPB) + (size_t)S.u0.pm * 256 * D * 2; S.u0.b = (const char*)(ws + (S.u0.aux ? WS_WV : WS_WK)) + (size_t)S.u0.pn * 256 * D * 2;
            pg8::Gemm g{D, D, D}; EpiMemKV E{out + O_MKP, out + O_MVP};
            pg8::gemm_phase<EpiMemKV, pg8::OneUnit, true, true>(lds, g, S, E, wave0); }
    } SEAM(1);
    if constexpr (IN(2)) {
        sgemm(lds, (const bf16_t*)(ws + WS_HB) + (size_t)MP * FF, FF, (const bf16_t*)(ws + WS_WD1), FF, FF, 4 * (D / 64), BMapPlain{}, SEpiResid{ka.in(1), X32, 0.5f}, bx, G, wave0);
        pg8::Gemm g{FF, FF, FF}; pg8::StaticOrder S; S.init(ws + WS_HB, ws + WS_WD1, FF, FF, MP, D, G, bx); EpiResid E{ka.in(0), ka.in(1), X32, 0.5f};
        pg8::gemm_phase<EpiResid, pg8::StaticOrder, true, true>(lds, g, S, E, wave0);
        phase_memconv(ka, lds, vcu, G, wave0);
    } SEAM(2);
    if constexpr (IN(3)) { phase_ln(X32, XB, ka.in(12), ka.in(13), vcu, G, wave0); } SEAM(3);
    if constexpr (IN(4)) {
        sgemm(lds, XB + (size_t)MP * D, D, (const bf16_t*)(ws + WS_WMIX), D, D, 4 * 48, BMapMix{}, SEpiMixIn{out, ws}, bx, G, wave0);
        pg8::Gemm g{D, D, D}; pg8::StaticOrder S; S.init(XB, ws + WS_WMIX, D, D, MP, NMIX, G, bx); EpiMixIn E{out, ws};
        pg8::gemm_phase<EpiMixIn, pg8::StaticOrder, true, true>(lds, g, S, E, wave0);
    } SEAM(4);
    if constexpr (IN(5)) { phase_indexer(ka, lds, bx, G, wave0); phase_conv(ka, bx, G, wave0); if constexpr ((REPEAT_MASK >> 5) & 1) { xcd_barrier(bar); phase_indexer(ka, lds, bx, G, wave0); phase_conv(ka, bx, G, wave0); } } SEAM(5);
    if constexpr (IN(6)) { phase_attn(ka, lds, vcu, G, wave0); if constexpr ((REPEAT_MASK >> 6) & 1) { xcd_barrier(bar); phase_attn(ka, lds, vcu, G, wave0); } } SEAM(6);
    if constexpr (IN(7)) {
        sgemm(lds, (const bf16_t*)(ws + WS_YCAT) + (size_t)MP * D, D, (const bf16_t*)(ws + WS_WMO), D, D, 4 * (D / 64), BMapPlain{}, SEpiResid{X32 + (size_t)MP * D, X32, 1.0f}, bx, G, wave0);
        pg8::Gemm g{D, D, D}; pg8::StaticOrder S; S.init(ws + WS_YCAT, ws + WS_WMO, D, D, MP, D, G, bx); EpiResid E{X32, X32 + (size_t)MP * D, X32, 1.0f};
        pg8::gemm_phase<EpiResid, pg8::StaticOrder, true, true>(lds, g, S, E, wave0);
    } SEAM(7);
    if constexpr (IN(8)) { phase_ln(X32, XB, ka.in(17), ka.in(18), vcu, G, wave0); } SEAM(8);
    if constexpr (IN(9)) {
        sgemm(lds, XB + (size_t)MP * D, D, (const bf16_t*)(ws + WS_WQ), D, D, 4 * (D / 64), BMapPlain{}, SEpiBf16{(bf16_t*)(ws + WS_QM)}, bx, G, wave0);
        pg8::Gemm g{D, D, D}; pg8::StaticOrder S; S.init(XB, ws + WS_WQ, D, D, MP, D, G, bx); EpiBf16 E{(bf16_t*)(ws + WS_QM), D};
        pg8::gemm_phase<EpiBf16, pg8::StaticOrder, true, true>(lds, g, S, E, wave0);
    } SEAM(9);
    if constexpr (IN(10)) {
        MemOrder MO{(const char*)(ws + WS_QM), (const char*)(ws + WS_MK), G, bx};
        for (int i = 0;; ++i) { pg8::OneUnit S; if (!MO.next(i, S.u0)) break; pg8::Gemm g{D, D, 256}; EpiSoftmaxP E{(bf16_t*)(ws + WS_PM)};
            pg8::gemm_phase<EpiSoftmaxP, pg8::OneUnit, false, true>(lds, g, S, E, wave0); }
    } SEAM(10);
    if constexpr (IN(11)) {
        MemOrder MO{(const char*)(ws + WS_PM), (const char*)(ws + WS_MVT), G, bx}; pg8::Gemm g{D, D, 256}; EpiBf16Filt E{(bf16_t*)(ws + WS_OM)};
        pg8::gemm_phase<EpiBf16Filt, MemOrder, true, true>(lds, g, MO, E, wave0);
    } SEAM(11);
    if constexpr ((REPEAT_MASK >> 10) & 1) {
    {
        MemOrder MO{(const char*)(ws + WS_QM), (const char*)(ws + WS_MK), G, bx};
        for (int i = 0;; ++i) { pg8::OneUnit S; if (!MO.next(i, S.u0)) break; pg8::Gemm g{D, D, 256}; EpiSoftmaxP E{(bf16_t*)(ws + WS_PM)};
            pg8::gemm_phase<EpiSoftmaxP, pg8::OneUnit, false, true>(lds, g, S, E, wave0); }
    } xcd_barrier(bar);
    {
        MemOrder MO{(const char*)(ws + WS_PM), (const char*)(ws + WS_MVT), G, bx}; pg8::Gemm g{D, D, 256}; EpiBf16Filt E{(bf16_t*)(ws + WS_OM)};
        pg8::gemm_phase<EpiBf16Filt, MemOrder, true, true>(lds, g, MO, E, wave0);
    } xcd_barrier(bar);
    }
    if constexpr (IN(12)) {
        sgemm(lds, (const bf16_t*)(ws + WS_OM) + (size_t)MP * D, D, (const bf16_t*)(ws + WS_WO), D, D, 4 * (D / 64), BMapPlain{}, SEpiResid{X32 + (size_t)MP * D, X32, 1.0f}, bx, G, wave0);
        pg8::Gemm g{D, D, D}; pg8::StaticOrder S; S.init(ws + WS_OM, ws + WS_WO, D, D, MP, D, G, bx); EpiResid E{X32, X32 + (size_t)MP * D, X32, 1.0f};
        pg8::gemm_phase<EpiResid, pg8::StaticOrder, true, true>(lds, g, S, E, wave0);
    } SEAM(12);
    if constexpr (IN(13)) { phase_ln(X32, XB, ka.in(23), ka.in(24), vcu, G, wave0); } SEAM(13);
    if constexpr (IN(14)) {
        sgemm(lds, XB + (size_t)MP * D, D, (const bf16_t*)(ws + WS_WGU2), D, D, 4 * (FF / 32), BMapPair{}, SEpiGateUp{(bf16_t*)(ws + WS_HB)}, bx, G, wave0);
        pg8::Gemm g{D, D, D}; pg8::StaticOrder S; S.init(XB, ws + WS_WGU2, D, D, MP, NGU, G, bx); EpiGateUp E{(bf16_t*)(ws + WS_HB)};
        pg8::gemm_phase<EpiGateUp, pg8::StaticOrder, true, true>(lds, g, S, E, wave0);
    } SEAM(14);
    if constexpr (IN(15)) {
        sgemm(lds, (const bf16_t*)(ws + WS_HB) + (size_t)MP * FF, FF, (const bf16_t*)(ws + WS_WD2), FF, FF, 4 * (D / 64), BMapPlain{}, SEpiResid{X32 + (size_t)MP * D, X32, 0.5f}, bx, G, wave0);
        pg8::Gemm g{FF, FF, FF}; pg8::StaticOrder S; S.init(ws + WS_HB, ws + WS_WD2, FF, FF, MP, D, G, bx); EpiResid E{X32, X32 + (size_t)MP * D, X32, 0.5f};
        pg8::gemm_phase<EpiResid, pg8::StaticOrder, true, true>(lds, g, S, E, wave0);
    } SEAM(15);
    if constexpr (IN(16)) { phase_ln(X32, XB, ka.in(28), ka.in(29), vcu, G, wave0, (const unsigned*)(ws + WS_CTL) + 16); }
#undef IN
#undef SEAM
}

#include <utility>
template <int LO, int HI> static bool set_attr1() { auto kp = &fwd_kernel<LO, HI>; return hipFuncSetAttribute((const void*)kp, hipFuncAttributeMaxDynamicSharedMemorySize, LDS_BYTES) == hipSuccess; }
template <int LO, int HI> static void launch1(int grid, hipStream_t stream, const Args& a) { auto kp = &fwd_kernel<LO, HI>; hipLaunchKernelGGL(kp, dim3(grid), dim3(NWAVES * 64), LDS_BYTES, stream, a); }
#if MK_N_LAUNCHES == 1
static bool set_attrs() { return set_attr1<0, 17>(); }
#else
template <int... P> static bool set_attrs_t(std::integer_sequence<int, P...>) { bool ok = true; ((ok = set_attr1<P, P + 1>() && ok), ...); return ok; }
static bool set_attrs() { return set_attrs_t(std::make_integer_sequence<int, 17>{}); }
template <int... P> static void launch_all(int grid, hipStream_t stream, const Args& a, std::integer_sequence<int, P...>) { (launch1<P, P + 1>(grid, stream, a), ...); }
#endif
extern "C" void kernel_launch(void* const* d_in, const int* in_sizes, int n_in, void* d_out, int out_size, void* d_ws, size_t ws_size, hipStream_t stream) {
    static int grid = 0;
    if (grid == 0) {
        if (n_in != 30 || (size_t)out_size != O_END || ws_size < WS_END) { fprintf(stderr, "kernel_launch: unexpected shapes: n_in %d out %d (want %zu) ws %zu (want %zu)\n", n_in, out_size, (size_t)O_END, ws_size, (size_t)WS_END); grid = -1; return; }
        int dev = 0, cus = 0;
        if (hipGetDevice(&dev) != hipSuccess || hipDeviceGetAttribute(&cus, hipDeviceAttributeMultiprocessorCount, dev) != hipSuccess) { grid = -1; return; }
        if (!set_attrs()) { fprintf(stderr, "kernel_launch: hipFuncSetAttribute failed\n"); grid = -1; return; }
        (void)hipGetLastError();
        grid = cus > 256 ? 256 : cus;
    }
    if (grid < 0) return;
    (void)hipMemsetAsync((char*)d_ws + WS_CTL, 0, CTL_BYTES, stream);
    Args a{};
    for (int i = 0; i < 30; ++i) a.in[i] = (const float*)d_in[i];
    a.out = (float*)d_out; a.ws = (unsigned char*)d_ws;
#if MK_N_LAUNCHES == 1
    launch1<0, 17>(grid, stream, a);
#else
    launch_all(grid, stream, a, std::make_integer_sequence<int, 17>{});
#endif
}
```
